# Optimizing an MI355X kernel written in HIP

```python
import jax, jax.numpy as jnp
from jax import lax
import numpy as np

D_MODEL = 2048
BATCH = 2
SEQ = 8192
DEPTH = 4
DEC_BATCH = 8
DEC_SEQ = 16
PAST_LEN = 2048

CHUNK = 64
CM_BLOCK = 128
CM_GROUPS = 4
CM_DIM = D_MODEL // 16
GLA_HEADS = 4
GLA_DK = D_MODEL // 32
GLA_DV = D_MODEL // 16
GLA_RANK = 16
GLA_TAU = 16.0
SB_HEADS = 8
SB_DIM = D_MODEL // 16
SB_BLOCK = 128
D_FF = 11 * D_MODEL // 4
CONV_W = 3
EPS = 1e-6

CM_W = CM_GROUPS * CM_DIM
GLA_K_W = GLA_HEADS * GLA_DK
GLA_V_W = GLA_HEADS * GLA_DV
SB_W = SB_HEADS * SB_DIM
MIX_W = CM_W + GLA_V_W + SB_W
IN_SIZES = (CM_W, CM_W, GLA_K_W, GLA_K_W, GLA_V_W, GLA_V_W, GLA_RANK, SB_W, SB_W, SB_W)
IN_W = CM_W * 2 + GLA_K_W * 2 + GLA_V_W * 2 + GLA_RANK + SB_W * 3

kernel_name = "hybrid_streaming_encoder_step"


def _rms_norm(x, g):
    xf = x.astype(jnp.float32)
    y = xf * lax.rsqrt(jnp.mean(xf * xf, axis=-1, keepdims=True) + EPS)
    return (y * g).astype(x.dtype)


def _split_in(proj):
    offsets = np.cumsum(IN_SIZES)[:-1].tolist()
    return jnp.split(proj, offsets, axis=-1)


def _chunk_mlp(u, v, ws, b, prompt):
    u = jax.nn.gelu(u)
    vf = jax.nn.gelu(v).astype(jnp.float32)
    mu = jnp.mean(vf, axis=-1, keepdims=True)
    var = jnp.mean(jnp.square(vf - mu), axis=-1, keepdims=True)
    vn = ((vf - mu) * lax.rsqrt(var + EPS)).astype(v.dtype)
    pos = jnp.arange(CM_BLOCK)
    mask = (pos[None, :] // CHUNK) <= (pos[:, None] // CHUNK)
    wsm = jnp.where(mask, ws, 0.0)
    bsz, t, g, c = vn.shape
    if prompt:
        vb = vn.reshape(bsz, t // CM_BLOCK, CM_BLOCK, g, c)
        s = jnp.einsum('gij,bnjgc->bnigc', wsm, vb) + b.T[:, :, None]
        s = s.reshape(bsz, t, g, c)
    else:
        s = jnp.einsum('gij,bjgc->bigc', wsm[:, :t, :t], vn) + b[:, :t].T[:, :, None]
    return u * s, vn


def _gla(q, k, v, log_a, s0, chunk):
    bsz, t, h, _ = q.shape
    dv = v.shape[-1]
    n = t // chunk

    def to_chunks(a):
        return jnp.moveaxis(a.astype(jnp.float32).reshape(bsz, n, chunk, h, a.shape[-1]), 1, 0)

    tri = jnp.tril(jnp.ones((chunk, chunk), dtype=bool))

    def step(s, inp):
        qc, kc, vc, ac = inp
        cum = jnp.cumsum(ac, axis=1)
        qe = qc * jnp.exp(cum)
        ke = kc * jnp.exp(-cum)
        att = jnp.where(tri, jnp.einsum('bthd,bshd->bhts', qe, ke), 0.0)
        o = jnp.einsum('bhts,bshv->bthv', att, vc) + jnp.einsum('bthd,bhdv->bthv', qe, s)
        last = cum[:, -1]
        kd = kc * jnp.exp(last[:, None] - cum)
        s = jnp.exp(last)[..., None] * s + jnp.einsum('bshd,bshv->bhdv', kd, vc)
        return s, o

    s, o = lax.scan(step, s0.astype(jnp.float32),
                    (to_chunks(q), to_chunks(k), to_chunks(v), to_chunks(log_a)))
    o = jnp.moveaxis(o, 0, 1).reshape(bsz, t, h, dv)
    return o.astype(v.dtype), s.astype(v.dtype)


def _sb_block(q, k, v, q_start):
    tq, tk = q.shape[1], k.shape[1]
    z = jnp.einsum('bqhd,bkhd->bhqk', q, k).astype(jnp.float32) * (SB_DIM ** -0.5)
    mask = jnp.arange(tk)[None, :] < (q_start + jnp.arange(tq))[:, None]
    log_beta = jax.nn.log_sigmoid(z)
    log_stay = jnp.where(mask, jax.nn.log_sigmoid(-z), 0.0)
    later = lax.cumsum(log_stay, axis=3, reverse=True) - log_stay
    a = jnp.where(mask, jnp.exp(log_beta + later), 0.0)
    return jnp.einsum('bhqk,bkhd->bqhd', a.astype(v.dtype), v)


def _stick_breaking(q, k, v, k_past, v_past, prompt):
    if prompt:
        t = q.shape[1]
        outs = []
        for start in range(0, t, SB_BLOCK):
            end = start + SB_BLOCK
            outs.append(_sb_block(q[:, start:end], k[:, :end], v[:, :end], start))
        return jnp.concatenate(outs, axis=1)
    kk = jnp.concatenate([k_past.astype(k.dtype), k], axis=1)
    vv = jnp.concatenate([v_past.astype(v.dtype), v], axis=1)
    return _sb_block(q, kk, vv, k_past.shape[1])


def _causal_dwconv(hid, prev, w, b):
    t = hid.shape[1]
    hp = jnp.concatenate([prev.astype(hid.dtype), hid], axis=1)
    out = b + w[0] * hp[:, 0:t]
    for i in range(1, CONV_W):
        out = out + w[i] * hp[:, i:i + t]
    return out, hp[:, t:]


def _layer(x, lp, k_past, v_past, gla_s0, conv_prev, prompt):
    bsz, t, _ = x.shape
    hd = lambda a, n: a.reshape(bsz, t, n, -1)
    h = _rms_norm(x, lp['norm1_g'])
    cu, cv, gq, gk, gv, gr, glr, sq, sk, sv = _split_in(h @ lp['w_in'])
    oa, cm_v = _chunk_mlp(hd(cu, CM_GROUPS), hd(cv, CM_GROUPS), lp['cm_ws'], lp['cm_b'], prompt)
    log_a = jax.nn.log_sigmoid((glr @ lp['gla_w2'] + lp['gla_b']).astype(jnp.float32)) / GLA_TAU
    ob, gla_s = _gla(hd(gq, GLA_HEADS) * (GLA_DK ** -0.5), hd(gk, GLA_HEADS), hd(gv, GLA_HEADS),
                     hd(log_a, GLA_HEADS), gla_s0, CHUNK if prompt else t)
    ob = _rms_norm(ob, lp['gla_norm_g']) * jax.nn.silu(hd(gr, GLA_HEADS))
    q = _rms_norm(hd(sq, SB_HEADS), lp['sb_q_g'])
    k = _rms_norm(hd(sk, SB_HEADS), lp['sb_k_g'])
    v = hd(sv, SB_HEADS)
    oc = _stick_breaking(q, k, v, k_past, v_past, prompt)
    mix = jnp.concatenate([oa.reshape(bsz, t, -1), ob.reshape(bsz, t, -1),
                           oc.reshape(bsz, t, -1)], axis=-1)
    x = x + mix @ lp['w_out']
    h2 = _rms_norm(x, lp['norm2_g'])
    g, conv_state = _causal_dwconv(h2 @ lp['ffn_w_gate'], conv_prev, lp['ffn_conv_w'], lp['ffn_conv_b'])
    x = x + (jax.nn.silu(g) * (h2 @ lp['ffn_w_up'])) @ lp['ffn_w_down']
    return x, k, v, gla_s, conv_state, cm_v


def setup_inputs(seed: int = 0) -> dict:
    key = jax.random.key(seed)
    ks = jax.random.split(key, 24)
    nrm = lambda k, shape, scale: jax.random.normal(k, shape, jnp.float32) * scale
    return {
        'x_prompt': nrm(ks[0], (BATCH, SEQ, D_MODEL), 1.0),
        'x_sample': nrm(ks[1], (DEC_BATCH, DEC_SEQ, D_MODEL), 1.0),
        'cache_sb_k': nrm(ks[2], (DEPTH, DEC_BATCH, PAST_LEN, SB_HEADS, SB_DIM), 1.0),
        'cache_sb_v': nrm(ks[3], (DEPTH, DEC_BATCH, PAST_LEN, SB_HEADS, SB_DIM), 1.0),
        'state_gla': nrm(ks[4], (DEPTH, DEC_BATCH, GLA_HEADS, GLA_DK, GLA_DV), 1.0),
        'state_ffn_conv': nrm(ks[5], (DEPTH, DEC_BATCH, CONV_W - 1, D_FF), 1.0),
        'norm1_g': 1.0 + nrm(ks[6], (DEPTH, D_MODEL), 0.01),
        'w_in': nrm(ks[7], (DEPTH, D_MODEL, IN_W), D_MODEL ** -0.5),
        'cm_ws': nrm(ks[8], (DEPTH, CM_GROUPS, CM_BLOCK, CM_BLOCK), CM_BLOCK ** -0.5),
        'cm_b': 1.0 + nrm(ks[9], (DEPTH, CM_GROUPS, CM_BLOCK), 0.01),
        'gla_w2': nrm(ks[10], (DEPTH, GLA_RANK, GLA_K_W), GLA_RANK ** -0.5),
        'gla_b': nrm(ks[11], (DEPTH, GLA_K_W), 0.01),
        'gla_norm_g': 1.0 + nrm(ks[12], (DEPTH, GLA_HEADS, GLA_DV), 0.01),
        'sb_q_g': 1.0 + nrm(ks[13], (DEPTH, SB_DIM), 0.01),
        'sb_k_g': 1.0 + nrm(ks[14], (DEPTH, SB_DIM), 0.01),
        'w_out': nrm(ks[15], (DEPTH, MIX_W, D_MODEL), MIX_W ** -0.5),
        'norm2_g': 1.0 + nrm(ks[16], (DEPTH, D_MODEL), 0.01),
        'ffn_w_gate': nrm(ks[17], (DEPTH, D_MODEL, D_FF), D_MODEL ** -0.5),
        'ffn_w_up': nrm(ks[18], (DEPTH, D_MODEL, D_FF), D_MODEL ** -0.5),
        'ffn_conv_w': nrm(ks[19], (DEPTH, CONV_W, D_FF), CONV_W ** -0.5),
        'ffn_conv_b': nrm(ks[20], (DEPTH, D_FF), 0.01),
        'ffn_w_down': nrm(ks[21], (DEPTH, D_FF, D_MODEL), D_FF ** -0.5),
    }


def reference(x_prompt, x_sample, cache_sb_k, cache_sb_v, state_gla, state_ffn_conv,
              norm1_g, w_in, cm_ws, cm_b, gla_w2, gla_b, gla_norm_g, sb_q_g, sb_k_g,
              w_out, norm2_g, ffn_w_gate, ffn_w_up, ffn_conv_w, ffn_conv_b, ffn_w_down):
    yp, ys = x_prompt, x_sample
    bp = x_prompt.shape[0]
    kp_l, vp_l, sp_l, cp_l = [], [], [], []
    ks_l, vs_l, ss_l, cs_l, cmv_l = [], [], [], [], []
    for l in range(DEPTH):
        lp = {'norm1_g': norm1_g[l], 'w_in': w_in[l], 'cm_ws': cm_ws[l], 'cm_b': cm_b[l],
              'gla_w2': gla_w2[l], 'gla_b': gla_b[l], 'gla_norm_g': gla_norm_g[l],
              'sb_q_g': sb_q_g[l], 'sb_k_g': sb_k_g[l], 'w_out': w_out[l], 'norm2_g': norm2_g[l],
              'ffn_w_gate': ffn_w_gate[l], 'ffn_w_up': ffn_w_up[l], 'ffn_conv_w': ffn_conv_w[l],
              'ffn_conv_b': ffn_conv_b[l], 'ffn_w_down': ffn_w_down[l]}
        gla0 = jnp.zeros((bp, GLA_HEADS, GLA_DK, GLA_DV), jnp.float32)
        conv0 = jnp.zeros((bp, CONV_W - 1, D_FF), x_prompt.dtype)
        yp, kp, vp, sp, cp, _ = _layer(yp, lp, None, None, gla0, conv0, True)
        ys, ksn, vsn, ssn, csn, cmv = _layer(ys, lp, cache_sb_k[l], cache_sb_v[l],
                                             state_gla[l], state_ffn_conv[l], False)
        kp_l.append(kp); vp_l.append(vp); sp_l.append(sp); cp_l.append(cp)
        ks_l.append(ksn); vs_l.append(vsn); ss_l.append(ssn); cs_l.append(csn); cmv_l.append(cmv)
    sb_k_prompt = jnp.stack(kp_l)
    sb_v_prompt = jnp.stack(vp_l)
    gla_prompt = jnp.stack(sp_l)
    conv_prompt = jnp.stack(cp_l)
    sb_k_sample = jnp.stack(ks_l)
    sb_v_sample = jnp.stack(vs_l)
    gla_sample = jnp.stack(ss_l)
    conv_sample = jnp.stack(cs_l)
    cm_v_sample = jnp.stack(cmv_l)
    return (yp, ys, sb_k_prompt, sb_v_prompt, gla_prompt, conv_prompt,
            sb_k_sample, sb_v_sample, gla_sample, conv_sample, cm_v_sample)
```

```cpp
#include <hip/hip_runtime.h>
#include <cstdio>
#include <cstdint>
namespace pg8 {
#define PG8_LAS __attribute__((address_space(3)))
typedef unsigned short bf16_t;
typedef short bf16x8 __attribute__((ext_vector_type(8)));
typedef float f32x4 __attribute__((ext_vector_type(4)));
typedef unsigned u32x4 __attribute__((ext_vector_type(4)));
constexpr int BM = 256, BK = 64, HALF = 128, HTB = HALF * BK * 2  , STAGE_BYTES = 8 * HTB, NXCD = 8, WGM = 8;

__host__ __device__ __forceinline__ int lds_byte(int r, int c) { const int st = (r >> 4) * 2 + (c >> 5), rr = r & 15, cc = c & 31, ob = rr * 64 + cc * 2; return st * 1024 + (ob ^ (((ob >> 9) & 1) << 5)); }
__host__ __device__ __forceinline__ void stage_rc(int b, int& R, int& C) { const int st = b / 1024, sb = b % 1024, swz = sb ^ (((sb >> 9) & 1) << 5); R = (st >> 1) * 16 + swz / 64; C = (st & 1) * 32 + (swz % 64) / 2; }
__host__ __device__ __forceinline__ int perm32(int rho) { const int n = rho >> 4, i = rho & 15; return 8 * (i >> 2) + 4 * n + (i & 3); }

struct Unit { int pm, pn; };
struct Gemm { const bf16_t* A; const bf16_t* Bt; int M, N, K; };

struct StaticOrder {
    int nM, nN, nwg, G, c;
    __host__ __device__ void init(int M, int N, int G_, int c_) { nM = M / BM; nN = N / BM; nwg = nM * nN; G = G_; c = c_; }
    __host__ __device__ bool next(int i, Unit& u) const {
        const long L = (long)i * G + c; if (L >= nwg) return false;
        int wgid = (int)L; { const int q = nwg / NXCD, r = nwg % NXCD, xcd = wgid % NXCD, off = wgid / NXCD; wgid = (xcd < r ? xcd * (q + 1) : r * (q + 1) + (xcd - r) * q) + off; }
        const int nig = WGM * nN, gid = wgid / nig, fm = gid * WGM, gsz = (nM - fm) < WGM ? (nM - fm) : WGM;
        u.pm = fm + ((wgid % nig) % gsz); u.pn = (wgid % nig) / gsz; return true;
    }
    __device__ __forceinline__ void a_ready(const Unit&) const {}
    __device__ __forceinline__ void done(const Unit&) const {}
};

__device__ __forceinline__ unsigned cvt_pk_bf16(float lo, float hi) { unsigned r; asm volatile("v_cvt_pk_bf16_f32 %0, %1, %2" : "=v"(r) : "v"(lo), "v"(hi)); return r; }
typedef float f32x2 __attribute__((ext_vector_type(2)));
__device__ __forceinline__ f32x2 gelu_pk(f32x2 v) {
    const f32x2 av = __builtin_elementwise_abs(v), d = av * 0.2316418882f + 1.0f;
    f32x2 t; t.x = __builtin_amdgcn_rcpf(d.x); t.y = __builtin_amdgcn_rcpf(d.y);
    f32x2 q = t * 0.5307027145f + (-0.7265760135f); q = q * t + 0.7107068705f; q = q * t + (-0.142248368f); q = q * t + 0.127414796f; q = q * t;
    const f32x2 s = (v * v) * (-0.72134752044f);
    f32x2 e; e.x = __builtin_amdgcn_exp2f(s.x); e.y = __builtin_amdgcn_exp2f(s.y);
    const f32x2 m = v * (q * e), r = v - m;
    f32x2 o; o.x = v.x < 0.f ? m.x : r.x; o.y = v.y < 0.f ? m.y : r.y; return o;
}

template <int ACT  > struct EpiBf16 {
    static constexpr bool PERM = true, AFTER_DRAIN = false; static_assert(ACT == 0 || ACT == 1, "EpiBf16: ACT is 0 (none) or 1 (gelu_pk)");
    bf16_t* O; int ldc; const float* bias; int split_cols; size_t split_stride; float scale0;
    __device__ __forceinline__ void operator()(const f32x4 (&acc)[2][2][4][2], const Unit& u, int wr, int wc, int fr, int fq) const {
        const int row0 = u.pm * BM + wr * 64 + fr; int colt = u.pn * BM; bf16_t* base = O;
        float sc = 1.f; if (split_cols) { const int t = colt / split_cols; base += (size_t)t * split_stride; colt -= t * split_cols; if (t == 0) sc = scale0; }
        const int col0 = colt + wc * 32 + 8 * fq, bcol0 = u.pn * BM + wc * 32 + 8 * fq;
        f32x4 bv[2][2];
#pragma unroll
        for (int bj = 0; bj < 2; ++bj)
#pragma unroll
            for (int n = 0; n < 2; ++n) bv[bj][n] = bias ? *(const f32x4*)(bias + bcol0 + bj * HALF + 4 * n) : (f32x4){0.f, 0.f, 0.f, 0.f};
#pragma unroll
        for (int ai = 0; ai < 2; ++ai)
#pragma unroll
            for (int m = 0; m < 4; ++m) { bf16_t* rowp = base + (size_t)(row0 + ai * HALF + m * 16) * ldc + col0;
#pragma unroll
                for (int bj = 0; bj < 2; ++bj) { f32x4 v0 = acc[ai][bj][m][0] + bv[bj][0], v1 = acc[ai][bj][m][1] + bv[bj][1];
                    if (ACT == 1) { f32x2 a = gelu_pk((f32x2){v0[0], v0[1]}), b = gelu_pk((f32x2){v0[2], v0[3]}), c = gelu_pk((f32x2){v1[0], v1[1]}), d = gelu_pk((f32x2){v1[2], v1[3]});
                        v0 = (f32x4){a.x, a.y, b.x, b.y}; v1 = (f32x4){c.x, c.y, d.x, d.y}; }
                    v0 = v0 * sc; v1 = v1 * sc; u32x4 w; w.x = cvt_pk_bf16(v0[0], v0[1]); w.y = cvt_pk_bf16(v0[2], v0[3]); w.z = cvt_pk_bf16(v1[0], v1[1]); w.w = cvt_pk_bf16(v1[2], v1[3]);
                    *(u32x4*)(rowp + bj * HALF) = w; } }
    }
};

struct EpiResF32 {
    static constexpr bool PERM = false, AFTER_DRAIN = false;
    float* X; int ldc; int mreal;
    __device__ __forceinline__ void operator()(const f32x4 (&acc)[2][2][4][2], const Unit& u, int wr, int wc, int fr, int fq) const {
        const int row0 = u.pm * BM + wr * 64 + fr, col0 = u.pn * BM + wc * 32 + 4 * fq;
#pragma unroll
        for (int ai = 0; ai < 2; ++ai)
#pragma unroll
            for (int m = 0; m < 4; ++m) { const int row = row0 + ai * HALF + m * 16;
                if (row < mreal) { float* rowp = X + (size_t)row * ldc + col0;
#pragma unroll
                    for (int bj = 0; bj < 2; ++bj)
#pragma unroll
                        for (int n = 0; n < 2; ++n) { f32x4* p = (f32x4*)(rowp + bj * HALF + n * 16); *p = *p + acc[ai][bj][m][n]; } }
                asm volatile("" ::: "memory"); }
    }
};
template <class Epi, class Sched, bool ALIGN_EPI = false, bool SP2 = false>
__device__ __forceinline__ void gemm_phase(PG8_LAS unsigned char* lds, const Gemm g, const Sched& S, const Epi& E) {
    int tid_l = threadIdx.x; asm volatile("" : "+v"(tid_l)); const int tid = tid_l, wid = __builtin_amdgcn_readfirstlane(tid >> 6), lane = tid & 63, wr = wid >> 2, wc = wid & 3, fr = lane & 15, fq = lane >> 4;
    const int K = g.K, nt = K / BK;
    unsigned voffA[2], voffB[2];
#pragma unroll
    for (int i = 0; i < 2; ++i) { int R, C; stage_rc(tid * 16 + i * 8192, R, C); const int Rb = Epi::PERM ? ((R & ~31) + perm32(R & 31)) : R;
        voffA[i] = (unsigned)(R * K + C) * 2u; voffB[i] = (unsigned)(Rb * K + C) * 2u; }
    const size_t kstep = (size_t)(BK * 2);
    const size_t hstep = (size_t)HALF * K * 2;
    const size_t tstep = 2 * hstep;
    const unsigned ldsw = (unsigned)wid * 1024u;
    const int aoff = lds_byte(wr * 64 + fr, fq * 8), boff = lds_byte(wc * 32 + fr, fq * 8);
#define PG8_SA(b, h) (((b) * 2 + (h)) * HTB)
#define PG8_SB(b, h) ((4 + (b) * 2 + (h)) * HTB)
#define PG8_STAGE(bufoff, gbase, voff) do { _Pragma("unroll") for (int _i = 0; _i < 2; ++_i) \
        __builtin_amdgcn_global_load_lds((const unsigned*)((const char*)(gbase) + (voff)[_i]), (PG8_LAS unsigned*)(lds + (bufoff) + ldsw + _i * 8192), 16, 0, 0); } while (0)
#define PG8_LDA(dst, b, h) do { _Pragma("unroll") for (int m = 0; m < 4; ++m) _Pragma("unroll") for (int k = 0; k < 2; ++k) dst[m][k] = *(const PG8_LAS bf16x8*)(lds + PG8_SA(b, h) + aoff + m * 2048 + k * 1024); } while (0)
#define PG8_LDB(dst, b, h) do { _Pragma("unroll") for (int n = 0; n < 2; ++n) _Pragma("unroll") for (int k = 0; k < 2; ++k) dst[n][k] = *(const PG8_LAS bf16x8*)(lds + PG8_SB(b, h) + boff + n * 2048 + k * 1024); } while (0)
#define PG8_MMA(ai, bj, At, Bt) do { __builtin_amdgcn_s_setprio(1); _Pragma("unroll") for (int m = 0; m < 4; ++m) _Pragma("unroll") for (int n = 0; n < 2; ++n) _Pragma("unroll") for (int k = 0; k < 2; ++k) \
        acc[ai][bj][m][n] = __builtin_amdgcn_mfma_f32_16x16x32_bf16(Bt[n][k], At[m][k], acc[ai][bj][m][n], 0, 0, 0); __builtin_amdgcn_s_setprio(0); } while (0)
#define PG8_WAIT_V(n) asm volatile("s_waitcnt vmcnt(" #n ")" ::: "memory")
#define PG8_WAIT_L(n) asm volatile("s_waitcnt lgkmcnt(" #n ")" ::: "memory")
#define PG8_BAR __builtin_amdgcn_s_barrier()
#define PG8_SCHED __builtin_amdgcn_sched_barrier(0)
    Unit cur, nxt; int ui = 0;
    if (!S.next(0, cur)) return;
    f32x4 acc[2][2][4][2];
#pragma unroll
    for (int a = 0; a < 2; ++a)
#pragma unroll
        for (int b = 0; b < 2; ++b)
#pragma unroll
            for (int m = 0; m < 4; ++m)
#pragma unroll
                for (int n = 0; n < 2; ++n) acc[a][b][m][n] = (f32x4){0.f, 0.f, 0.f, 0.f};
    bf16x8 At[4][2], B0[2][2], B1[2][2];
    const char* cA = (const char*)g.A + (size_t)cur.pm * tstep; const char* cB = (const char*)g.Bt + (size_t)cur.pn * tstep;
    S.a_ready(cur);
    if constexpr (SP2) {
        PG8_STAGE(PG8_SB(0, 0), cB, voffB); PG8_STAGE(PG8_SB(0, 1), cB + hstep, voffB); PG8_STAGE(PG8_SA(0, 0), cA, voffA); PG8_STAGE(PG8_SA(0, 1), cA + hstep, voffA);
        if (wr == 1) PG8_BAR;
        PG8_WAIT_V(2); PG8_BAR;
        PG8_STAGE(PG8_SB(1, 0), cB + kstep, voffB); PG8_STAGE(PG8_SA(1, 0), cA + kstep, voffA); PG8_STAGE(PG8_SB(1, 1), cB + hstep + kstep, voffB);
        PG8_WAIT_V(6); PG8_BAR;
    } else {
        PG8_STAGE(PG8_SB(0, 0), cB, voffB); PG8_STAGE(PG8_SA(0, 0), cA, voffA); PG8_STAGE(PG8_SB(0, 1), cB + hstep, voffB); PG8_STAGE(PG8_SA(0, 1), cA + hstep, voffA);
        if (wr == 1) PG8_BAR;
        PG8_WAIT_V(4); PG8_BAR;
        PG8_STAGE(PG8_SB(1, 0), cB + kstep, voffB); PG8_STAGE(PG8_SA(1, 0), cA + kstep, voffA); PG8_STAGE(PG8_SB(1, 1), cB + hstep + kstep, voffB);
        PG8_WAIT_V(6); PG8_BAR;
    }
    for (;;) {
        const bool has_next = S.next(ui + 1, nxt);
        const char* nA = has_next ? (const char*)g.A + (size_t)nxt.pm * tstep : cA; const char* nB = has_next ? (const char*)g.Bt + (size_t)nxt.pn * tstep : cB;
        for (int t = 0; t < nt; t += 2) {
            const bool last = (t == nt - 2);
            const char* a1 = cA + (size_t)(t + 1) * kstep;
            const char* a2 = last ? nA : cA + (size_t)(t + 2) * kstep; const char* b2 = last ? nB : cB + (size_t)(t + 2) * kstep;
            const char* a3 = a2 + kstep; const char* b3 = b2 + kstep;
            if (last && has_next) S.a_ready(nxt);
            if constexpr (SP2) {
            PG8_LDB(B0, 0, 0); PG8_LDB(B1, 0, 1); PG8_SCHED; PG8_LDA(At, 0, 0); PG8_STAGE(PG8_SA(1, 1), a1 + hstep, voffA);
            PG8_WAIT_V(8); PG8_WAIT_L(0); PG8_BAR; PG8_MMA(0, 0, At, B0); PG8_MMA(0, 1, At, B1); PG8_BAR; PG8_SCHED;
            PG8_LDA(At, 0, 1); PG8_STAGE(PG8_SB(0, 0), b2, voffB); PG8_STAGE(PG8_SB(0, 1), b2 + hstep, voffB); PG8_STAGE(PG8_SA(0, 0), a2, voffA);
            PG8_WAIT_V(8); PG8_WAIT_L(0); PG8_BAR; PG8_MMA(1, 0, At, B0); PG8_MMA(1, 1, At, B1); PG8_BAR; PG8_SCHED;
            PG8_LDB(B0, 1, 0); PG8_LDB(B1, 1, 1); PG8_SCHED; PG8_LDA(At, 1, 0); PG8_STAGE(PG8_SA(0, 1), a2 + hstep, voffA);
            PG8_WAIT_V(8); PG8_WAIT_L(0); PG8_BAR; PG8_MMA(0, 0, At, B0); PG8_MMA(0, 1, At, B1); PG8_BAR; PG8_SCHED;
            PG8_LDA(At, 1, 1); PG8_STAGE(PG8_SB(1, 0), b3, voffB); PG8_STAGE(PG8_SB(1, 1), b3 + hstep, voffB); PG8_STAGE(PG8_SA(1, 0), a3, voffA);
            PG8_WAIT_V(8); PG8_WAIT_L(0); PG8_BAR; PG8_MMA(1, 0, At, B0); PG8_MMA(1, 1, At, B1); PG8_BAR; PG8_SCHED;
            } else {
            PG8_LDB(B0, 0, 0); PG8_SCHED; PG8_LDA(At, 0, 0); PG8_STAGE(PG8_SA(1, 1), a1 + hstep, voffA);
            PG8_WAIT_L(8); PG8_BAR; PG8_WAIT_L(0); PG8_MMA(0, 0, At, B0); PG8_BAR; PG8_SCHED;
            PG8_LDB(B1, 0, 1); PG8_STAGE(PG8_SB(0, 0), b2, voffB);
            PG8_BAR; PG8_WAIT_L(0); PG8_MMA(0, 1, At, B1); PG8_BAR;
            PG8_LDA(At, 0, 1); PG8_STAGE(PG8_SA(0, 0), a2, voffA);
            PG8_BAR; PG8_WAIT_L(0); PG8_MMA(1, 0, At, B0); PG8_BAR; PG8_SCHED;
            PG8_STAGE(PG8_SB(0, 1), b2 + hstep, voffB);
            PG8_WAIT_V(6); PG8_BAR; PG8_MMA(1, 1, At, B1); PG8_BAR;
            PG8_LDB(B0, 1, 0); PG8_SCHED; PG8_LDA(At, 1, 0); PG8_STAGE(PG8_SA(0, 1), a2 + hstep, voffA);
            PG8_WAIT_L(8); PG8_BAR; PG8_WAIT_L(0); PG8_MMA(0, 0, At, B0); PG8_BAR; PG8_SCHED;
            PG8_LDB(B1, 1, 1); PG8_STAGE(PG8_SB(1, 0), b3, voffB);
            PG8_BAR; PG8_WAIT_L(0); PG8_MMA(0, 1, At, B1); PG8_BAR;
            PG8_LDA(At, 1, 1); PG8_STAGE(PG8_SA(1, 0), a3, voffA);
            PG8_BAR; PG8_WAIT_L(0); PG8_MMA(1, 0, At, B0); PG8_BAR; PG8_SCHED;
            PG8_STAGE(PG8_SB(1, 1), b3 + hstep, voffB);
            PG8_WAIT_V(6); PG8_BAR; PG8_MMA(1, 1, At, B1); PG8_BAR;
            }
        }
        if constexpr (ALIGN_EPI) { if (wr == 0) PG8_BAR; }
        if constexpr (!Epi::AFTER_DRAIN) { E(acc, cur, wr, wc, fr, fq); S.done(cur); }
        if (!has_next) break;
#pragma unroll
        for (int a = 0; a < 2; ++a)
#pragma unroll
            for (int b = 0; b < 2; ++b)
#pragma unroll
                for (int m = 0; m < 4; ++m)
#pragma unroll
                    for (int n = 0; n < 2; ++n) acc[a][b][m][n] = (f32x4){0.f, 0.f, 0.f, 0.f};
        cur = nxt; cA = nA; cB = nB; ++ui;
        if constexpr (ALIGN_EPI) { if (wr == 1) PG8_BAR; }
    }
    PG8_WAIT_V(0);
    if constexpr (!ALIGN_EPI) { if (wr == 0) PG8_BAR; }
    PG8_BAR;
    if constexpr (Epi::AFTER_DRAIN) { E.fused(acc, cur, wr, wc, fr, fq, lds, wid, lane); S.done(cur); }
#undef PG8_SA
#undef PG8_SB
#undef PG8_STAGE
#undef PG8_LDA
#undef PG8_LDB
#undef PG8_MMA
#undef PG8_WAIT_V
#undef PG8_WAIT_L
#undef PG8_BAR
#undef PG8_SCHED
}
}
#define GAS __attribute__((address_space(1)))
#define LAS __attribute__((address_space(3)))
typedef unsigned short bf16;
typedef unsigned v4u __attribute__((ext_vector_type(4)));
typedef float f32x4 __attribute__((ext_vector_type(4)));
typedef short bf16x8 __attribute__((ext_vector_type(8)));
typedef GAS unsigned gu32;
typedef GAS unsigned long long gu64;
#define RLX_AGENT __ATOMIC_RELAXED, __HIP_MEMORY_SCOPE_AGENT
#define LDS_WAIT() asm volatile("s_waitcnt lgkmcnt(0)" ::: "memory")
#define VM_WAIT() asm volatile("s_waitcnt vmcnt(0)" ::: "memory")
__device__ __forceinline__ unsigned long long rt() { return __builtin_amdgcn_s_memrealtime(); }
__device__ __forceinline__ unsigned f2bf(float f) { unsigned u = __builtin_bit_cast(unsigned, f); return (u + 0x7fffu + ((u >> 16) & 1u)) >> 16; }
__device__ __forceinline__ unsigned pk2(float lo, float hi) { return f2bf(lo) | (f2bf(hi) << 16); }

#define XB_TMO      128
#define XB_XCNT(j)  (256  + 64 * (j))
#define XB_XSUB(j)  (1280 + 64 * (j))
#define XB_XGEN(j)  (2304 + 64 * (j))
#define XB_TOP      3328
#define XB_TOPGEN   3392
#define XCD_BAR_WORDS 3456
#define XB_SPIN_CAP (1u << 18)

__device__ __forceinline__ unsigned xb_ld(unsigned* p)              { return __hip_atomic_load(p, __ATOMIC_RELAXED, __HIP_MEMORY_SCOPE_AGENT); }
__device__ __forceinline__ unsigned xb_add(unsigned* p, unsigned v) { return __hip_atomic_fetch_add(p, v, __ATOMIC_RELAXED, __HIP_MEMORY_SCOPE_AGENT); }
__device__ __forceinline__ unsigned xb_xcc_id() { return (unsigned)__builtin_amdgcn_s_getreg((3 << 11) | 20) & 0xFu; }
#define XB_SPIN(cond, bar) do { unsigned _sp = 0; while (cond) { __builtin_amdgcn_s_sleep(1); \
    if ((++_sp & 255u) == 0u) { if (xb_ld(&(bar)[XB_TMO])) break; if (_sp > XB_SPIN_CAP) { atomicAdd(&(bar)[XB_TMO], 1u); break; } } } } while (0)

struct XcdBarrier {
    unsigned* bar; unsigned x;
    volatile LAS unsigned* st;
};

__device__ __forceinline__ XcdBarrier xcd_barrier_post(unsigned* bar, volatile LAS unsigned* st) {
    XcdBarrier b; b.bar = bar; b.x = xb_xcc_id(); b.st = st;
    if (threadIdx.x == 0) (void)xb_add(&bar[XB_XCNT(b.x)], 1u);
    return b;
}
__device__ __forceinline__ void xcd_barrier_complete(unsigned* bar, unsigned x, unsigned& nloc, unsigned& nx) {
    const unsigned G = gridDim.x * gridDim.y * gridDim.z;
    unsigned sum, cnt, mine, sp = 0u;
    for (;;) {
        sum = 0u; cnt = 0u; mine = 0u;
#pragma unroll
        for (unsigned j = 0; j < 16; ++j) { const unsigned c = xb_ld(&bar[XB_XCNT(j)]); sum += c; cnt += (c > 0u) ? 1u : 0u; mine = (j == x) ? c : mine; }
        if (sum == G) break;
        __builtin_amdgcn_s_sleep(1);
        if ((++sp & 255u) == 0u) { if (xb_ld(&bar[XB_TMO])) break; if (sp > XB_SPIN_CAP) { atomicAdd(&bar[XB_TMO], 1u); break; } }
    }
    nloc = mine > 0u ? mine : 1u; nx = cnt > 0u ? cnt : 1u;
}

__device__ __forceinline__ void xcd_barrier(const XcdBarrier& b) {
    asm volatile("s_waitcnt vmcnt(0)" ::: "memory");
    __syncthreads();
    if (threadIdx.x == 0) {
        unsigned* bar = b.bar;
        __builtin_amdgcn_s_waitcnt(0);
        unsigned nloc = b.st[0], nx = b.st[1];
        if (nloc == 0u) { xcd_barrier_complete(bar, b.x, nloc, nx); b.st[0] = nloc; b.st[1] = nx; }
        const unsigned old = xb_add(&bar[XB_XSUB(b.x)], 1u);
        const unsigned gen = old / nloc;
        if (old + 1u == (gen + 1u) * nloc) {
            __builtin_amdgcn_fence(__ATOMIC_RELEASE, "agent");
            asm volatile("s_waitcnt vmcnt(0)" ::: "memory");
            const unsigned og = xb_add(&bar[XB_TOP], 1u);
            const unsigned tg = og / nx;
            if (og + 1u == (tg + 1u) * nx) xb_add(&bar[XB_TOPGEN], 1u);
            else XB_SPIN(xb_ld(&bar[XB_TOPGEN]) == tg, bar);
            __builtin_amdgcn_fence(__ATOMIC_ACQUIRE, "agent");
            xb_add(&bar[XB_XGEN(b.x)], 1u);
            asm volatile("s_waitcnt vmcnt(0)" ::: "memory");
        } else {
            XB_SPIN(xb_ld(&bar[XB_XGEN(b.x)]) == gen, bar);
            __builtin_amdgcn_fence(__ATOMIC_ACQUIRE, "agent");
            asm volatile("s_waitcnt vmcnt(0)" ::: "memory");
        }
    }
    __syncthreads();
}

constexpr int DM = 2048, NBATCH = 2, SEQ = 8192, NL = 4, DECB = 8, DECS = 16, PAST = 2048;
constexpr int MP = NBATCH * SEQ;
constexpr int MS = DECB * DECS;
constexpr int MR = MP + MS;
constexpr int MT = 16640;
constexpr int INW = 5648, NIN = 5888, FF = 5632, NGU = 2 * FF;
constexpr int C_CU = 0, C_CV = 512, C_GQ = 1024, C_GK = 1280, C_GV = 1536, C_GR = 2048, C_SQ = 2560, C_SK = 3584, C_SV = 4608, C_LR = 5632;
constexpr float EPS = 1e-6f;
constexpr float QSCALE = 0.08838834764831845f * 1.4426950408889634f;

constexpr size_t O_Y = 0;
constexpr size_t O_KP = (size_t)MR * DM;
constexpr size_t O_VP = O_KP + (size_t)NL * MP * 1024;
constexpr size_t O_GP = O_VP + (size_t)NL * MP * 1024;
constexpr size_t O_CP = O_GP + (size_t)NL * NBATCH * 4 * 64 * 128;
constexpr size_t O_KS = O_CP + (size_t)NL * NBATCH * 2 * FF;
constexpr size_t O_VS = O_KS + (size_t)NL * MS * 1024;
constexpr size_t O_GS = O_VS + (size_t)NL * MS * 1024;
constexpr size_t O_CS = O_GS + (size_t)NL * DECB * 4 * 64 * 128;
constexpr size_t O_CM = O_CS + (size_t)NL * DECB * 2 * FF;
constexpr size_t O_END = O_CM + (size_t)NL * MS * 512;

constexpr size_t MiB = 1u << 20;
constexpr size_t WS_CTL = 0, CTL_ZERO_BYTES = 1 * MiB;
constexpr size_t SZ_WIN = (size_t)NIN * DM * 2, SZ_WOUT = (size_t)DM * DM * 2, SZ_WGU = (size_t)NGU * DM * 2, SZ_WDN = (size_t)DM * FF * 2;
constexpr size_t SZ_WL = SZ_WIN + SZ_WOUT + SZ_WGU + SZ_WDN;
constexpr size_t WS_W = 1 * MiB;
constexpr size_t WS_H = WS_W + NL * SZ_WL;
constexpr size_t WS_HID = WS_H + (size_t)MT * DM * 2;
constexpr size_t WS_RA = WS_HID + (size_t)MT * FF * 2;
constexpr size_t WS_PROJ = WS_RA;
constexpr size_t WS_MIX = WS_PROJ + (size_t)MT * NIN * 2;
constexpr size_t WS_GLAU = WS_MIX + (size_t)MT * DM * 2;
constexpr size_t WS_GLAD = WS_GLAU + (size_t)1024 * 8192 * 4;
constexpr size_t WS_GU = WS_RA;
constexpr size_t WS_END = WS_RA + (size_t)MT * NGU * 2;
static_assert(WS_GLAD + 1024 * 64 * 4 <= WS_END, "region A");
static_assert(WS_W % 256 == 0 && SZ_WL % 256 == 0 && WS_H % 256 == 0 && WS_HID % 256 == 0 && WS_RA % 256 == 0 && WS_MIX % 256 == 0 && WS_GLAU % 256 == 0, "alignment");

constexpr int CW_BAR = 4096;
constexpr int CW_Q = 16384;
static_assert((CW_Q + 64 * 64) * 4 <= (int)CTL_ZERO_BYTES, "ctl");

constexpr int SCR_BYTES = 139264;
constexpr int LCTL_OFF = SCR_BYTES;
constexpr int LDS_BYTES = 147456;
static_assert(LCTL_OFF + 256 <= LDS_BYTES, "lds");
constexpr int NWAVES = 8, NTHR = 512;

struct Args { const float* in[22]; float* out; unsigned char* ws; };
typedef const __attribute__((address_space(4))) Args* KArgs;
__device__ __forceinline__ KArgs kargs() { KArgs p = (KArgs)__builtin_amdgcn_kernarg_segment_ptr(); asm volatile("" : "+s"(p)); return p; }
__device__ __forceinline__ int fresh_tid() { int t = threadIdx.x; asm volatile("" : "+v"(t)); return t; }
__device__ __forceinline__ int fresh_bx() { int t = blockIdx.x; asm volatile("" : "+s"(t)); return t; }


__device__ __forceinline__ float bf_lo(unsigned w) { return __uint_as_float(w << 16); }
__device__ __forceinline__ float bf_hi(unsigned w) { return __uint_as_float(w & 0xffff0000u); }
__device__ __forceinline__ unsigned pkbf(float lo, float hi) { return pg8::cvt_pk_bf16(lo, hi); }
__device__ __forceinline__ float gelu_t(float x) { const float in = x + 0.044715f * x * x * x; return x / (1.f + __expf(-1.5957691216057308f * in)); }
__device__ __forceinline__ float silu_f(float x) { return x / (1.f + __expf(-x)); }
__device__ __forceinline__ float logsig_f(float x) { return fminf(x, 0.f) - __logf(1.f + __expf(-fabsf(x))); }
typedef float f32x2 __attribute__((ext_vector_type(2)));
template <int M> __device__ __forceinline__ float shx(float v) { static_assert(M >= 1 && M < 32, "shx"); return __int_as_float(__builtin_amdgcn_ds_swizzle(__float_as_int(v), 0x1f | (M << 10))); }
__device__ __forceinline__ float sum_x32(float v) { auto rr = __builtin_amdgcn_permlane32_swap(__float_as_uint(v), __float_as_uint(v), false, false); return __uint_as_float(rr[0]) + __uint_as_float(rr[1]); }
__device__ __forceinline__ float bperm(float v, int srclane) { return __int_as_float(__builtin_amdgcn_ds_bpermute(srclane << 2, __float_as_int(v))); }
typedef unsigned u32x2 __attribute__((ext_vector_type(2)));

__device__ __forceinline__ void transpose_item(const float* __restrict__ W, int ldw, int sc, int nv, int k0, bf16* __restrict__ WT, int K, int dst_row0, LAS float* scr, int lane) {
    const int j = lane & 31;
#pragma unroll 8
    for (int i = 0; i < 32; ++i) { const int kk = 2 * i + (lane >> 5); float v = 0.f; if (j < nv) v = W[(size_t)(k0 + kk) * ldw + sc + j]; scr[kk * 33 + j] = v; }
    LDS_WAIT(); asm volatile("" ::: "memory");
    const int c = lane & 7;
#pragma unroll
    for (int jj = 0; jj < 4; ++jj) { const int n = (lane >> 3) + 8 * jj; const LAS float* s = scr + (8 * c) * 33 + n;
        v4u o; o.x = pkbf(s[0 * 33], s[1 * 33]); o.y = pkbf(s[2 * 33], s[3 * 33]); o.z = pkbf(s[4 * 33], s[5 * 33]); o.w = pkbf(s[6 * 33], s[7 * 33]);
        *(GAS v4u*)(WT + (size_t)(dst_row0 + n) * K + k0 + 8 * c) = o; }
    LDS_WAIT(); asm volatile("" ::: "memory");
}

constexpr int IT_WIN = (DM / 64) * (NIN / 32), IT_WOUT = (DM / 64) * (DM / 32), IT_WG = (DM / 64) * (FF / 32), IT_WD = (FF / 64) * (DM / 32);
constexpr int IT_L = IT_WIN + IT_WOUT + 2 * IT_WG + IT_WD;

__device__ __forceinline__ void p0_prologue(KArgs a, LAS unsigned char* lds, int gw, int NGW, int wave, int lane, int gtid, int GT) {
    LAS float* scr = (LAS float*)(lds + wave * 8704);
    unsigned char* ws = a->ws;
    for (int it = gw; it < NL * IT_L; it += NGW) {
        const int l = it / IT_L; int r = it - l * IT_L;
        unsigned char* wl = ws + WS_W + (size_t)l * SZ_WL;
        if (r < IT_WIN) { const int nblk = NIN / 32, kb = r / nblk, nb = r - kb * nblk, d0 = nb * 32; int sc, nv;
            if (d0 < 2560) { sc = d0; nv = 32; } else if (d0 < 5632) { sc = d0 + 16; nv = 32; } else if (d0 == 5632) { sc = 2560; nv = 16; } else { sc = 0; nv = 0; }
            transpose_item(a->in[7] + (size_t)l * DM * INW, INW, sc, nv, kb * 64, (bf16*)wl, DM, d0, scr, lane); continue; }
        r -= IT_WIN;
        if (r < IT_WOUT) { const int nblk = DM / 32, kb = r / nblk, nb = r - kb * nblk;
            transpose_item(a->in[15] + (size_t)l * DM * DM, DM, nb * 32, 32, kb * 64, (bf16*)(wl + SZ_WIN), DM, nb * 32, scr, lane); continue; }
        r -= IT_WOUT;
        if (r < 2 * IT_WG) { const int up = r >= IT_WG ? 1 : 0; r -= up * IT_WG; const int nblk = FF / 32, kb = r / nblk, nb = r - kb * nblk, f0 = nb * 32;
            transpose_item(a->in[up ? 18 : 17] + (size_t)l * DM * FF, FF, f0, 32, kb * 64, (bf16*)(wl + SZ_WIN + SZ_WOUT), DM, (f0 >> 7) * 256 + (f0 & 127) + up * 128, scr, lane); continue; }
        r -= 2 * IT_WG;
        { const int nblk = DM / 32, kb = r / nblk, nb = r - kb * nblk;
            transpose_item(a->in[21] + (size_t)l * FF * DM, DM, nb * 32, 32, kb * 64, (bf16*)(wl + SZ_WIN + SZ_WOUT + SZ_WGU), FF, nb * 32, scr, lane); }
    }
    for (int m = gw; m < MR; m += NGW) {
        const float* src = m < MP ? a->in[0] + (size_t)m * DM : a->in[1] + (size_t)(m - MP) * DM;
        const GAS f32x4* s4 = (const GAS f32x4*)src + lane; GAS f32x4* d4 = (GAS f32x4*)(a->out + (size_t)m * DM) + lane;
#pragma unroll
        for (int j = 0; j < 8; ++j) d4[64 * j] = s4[64 * j];
    }
    { const v4u z = {0u, 0u, 0u, 0u};
      const int nH = (MT - MR) * DM * 2 / 16, nF = (MT - MR) * FF * 2 / 16;
      GAS v4u* pH = (GAS v4u*)(ws + WS_H + (size_t)MR * DM * 2); GAS v4u* pM = (GAS v4u*)(ws + WS_MIX + (size_t)MR * DM * 2); GAS v4u* pF = (GAS v4u*)(ws + WS_HID + (size_t)MR * FF * 2);
      for (int i = gtid; i < nH; i += GT) { pH[i] = z; pM[i] = z; }
      for (int i = gtid; i < nF; i += GT) pF[i] = z; }
}

__device__ __forceinline__ void norm_phase(const float* X, const float* __restrict__ g, bf16* H, int gw, int NGW, int lane) {
    const GAS f32x4* g4 = (const GAS f32x4*)g + lane;
    for (int m = gw; m < MR; m += NGW) {
        const GAS f32x4* xr = (const GAS f32x4*)(X + (size_t)m * DM) + lane;
        f32x4 v[8]; float ss = 0.f;
#pragma unroll
        for (int j = 0; j < 8; ++j) { v[j] = xr[64 * j]; ss += (v[j].x * v[j].x + v[j].y * v[j].y) + (v[j].z * v[j].z + v[j].w * v[j].w); }
        ss += shx<1>(ss); ss += shx<2>(ss); ss += shx<4>(ss); ss += shx<8>(ss); ss += shx<16>(ss); ss = sum_x32(ss);
        const float rs = rsqrtf(ss * (1.f / DM) + EPS);
        GAS u32x2* o8 = (GAS u32x2*)(H + (size_t)m * DM) + lane;
#pragma unroll
        for (int j = 0; j < 8; ++j) { const f32x4 gg = g4[64 * j]; u32x2 w; w.x = pkbf(v[j].x * rs * gg.x, v[j].y * rs * gg.y); w.y = pkbf(v[j].z * rs * gg.z, v[j].w * rs * gg.w); o8[64 * j] = w; }
    }
}

__device__ __forceinline__ void unpack16(const v4u a, const v4u b, float (&x)[16]) {
    x[0] = bf_lo(a.x); x[1] = bf_hi(a.x); x[2] = bf_lo(a.y); x[3] = bf_hi(a.y); x[4] = bf_lo(a.z); x[5] = bf_hi(a.z); x[6] = bf_lo(a.w); x[7] = bf_hi(a.w);
    x[8] = bf_lo(b.x); x[9] = bf_hi(b.x); x[10] = bf_lo(b.y); x[11] = bf_hi(b.y); x[12] = bf_lo(b.z); x[13] = bf_hi(b.z); x[14] = bf_lo(b.w); x[15] = bf_hi(b.w);
}
__device__ __forceinline__ void unpack8(const v4u a, float (&x)[8]) {
    x[0] = bf_lo(a.x); x[1] = bf_hi(a.x); x[2] = bf_lo(a.y); x[3] = bf_hi(a.y); x[4] = bf_lo(a.z); x[5] = bf_hi(a.z); x[6] = bf_lo(a.w); x[7] = bf_hi(a.w);
}
__device__ __forceinline__ v4u pack8f(const float (&x)[8]) { v4u o; o.x = pkbf(x[0], x[1]); o.y = pkbf(x[2], x[3]); o.z = pkbf(x[4], x[5]); o.w = pkbf(x[6], x[7]); return o; }

__device__ __forceinline__ void prep_row(bf16* PROJ, int r, int l, const float* __restrict__ gq, const float* __restrict__ gk, float* out, int lane) {
    bf16* prow = PROJ + (size_t)r * NIN;
    const int d0 = (lane & 7) * 16;
    { GAS v4u* p = (GAS v4u*)(prow + C_SQ + lane * 16); const v4u a = p[0], b = p[1]; float x[16]; unpack16(a, b, x); float ss = 0.f;
#pragma unroll
      for (int i = 0; i < 16; ++i) ss += x[i] * x[i];
      ss += shx<1>(ss); ss += shx<2>(ss); ss += shx<4>(ss);
      const float rs = rsqrtf(ss * (1.f / 128.f) + EPS) * QSCALE; float y[8], z[8];
#pragma unroll
      for (int i = 0; i < 8; ++i) { y[i] = x[i] * rs * gq[d0 + i]; z[i] = x[8 + i] * rs * gq[d0 + 8 + i]; }
      p[0] = pack8f(y); p[1] = pack8f(z); }
    { GAS v4u* p = (GAS v4u*)(prow + C_SK + lane * 16); const v4u a = p[0], b = p[1]; float x[16]; unpack16(a, b, x); float ss = 0.f;
#pragma unroll
      for (int i = 0; i < 16; ++i) ss += x[i] * x[i];
      ss += shx<1>(ss); ss += shx<2>(ss); ss += shx<4>(ss);
      const float rs = rsqrtf(ss * (1.f / 128.f) + EPS); float y[8], z[8];
#pragma unroll
      for (int i = 0; i < 8; ++i) { y[i] = x[i] * rs * gk[d0 + i]; z[i] = x[8 + i] * rs * gk[d0 + 8 + i]; }
      p[0] = pack8f(y); p[1] = pack8f(z);
      float* ok = r < MP ? out + O_KP + ((size_t)l * MP + r) * 1024 : out + O_KS + ((size_t)l * MS + (r - MP)) * 1024;
      GAS f32x4* o4 = (GAS f32x4*)(ok + lane * 16);
      o4[0] = (f32x4){y[0], y[1], y[2], y[3]}; o4[1] = (f32x4){y[4], y[5], y[6], y[7]}; o4[2] = (f32x4){z[0], z[1], z[2], z[3]}; o4[3] = (f32x4){z[4], z[5], z[6], z[7]}; }
    { const GAS v4u* p = (const GAS v4u*)(prow + C_SV + lane * 16); const v4u a = p[0], b = p[1]; float x[16]; unpack16(a, b, x);
      float* ov = r < MP ? out + O_VP + ((size_t)l * MP + r) * 1024 : out + O_VS + ((size_t)l * MS + (r - MP)) * 1024;
      GAS f32x4* o4 = (GAS f32x4*)(ov + lane * 16);
      o4[0] = (f32x4){x[0], x[1], x[2], x[3]}; o4[1] = (f32x4){x[4], x[5], x[6], x[7]}; o4[2] = (f32x4){x[8], x[9], x[10], x[11]}; o4[3] = (f32x4){x[12], x[13], x[14], x[15]}; }
    { GAS v4u* p = (GAS v4u*)(prow + C_CV + lane * 8); const v4u a = p[0]; float x[8]; unpack8(a, x); float s = 0.f;
#pragma unroll
      for (int i = 0; i < 8; ++i) { x[i] = gelu_t(x[i]); s += x[i]; }
      s += shx<1>(s); s += shx<2>(s); s += shx<4>(s); s += shx<8>(s);
      const float mu = s * (1.f / 128.f); float q = 0.f;
#pragma unroll
      for (int i = 0; i < 8; ++i) { x[i] -= mu; q += x[i] * x[i]; }
      q += shx<1>(q); q += shx<2>(q); q += shx<4>(q); q += shx<8>(q);
      const float rs = rsqrtf(q * (1.f / 128.f) + EPS);
#pragma unroll
      for (int i = 0; i < 8; ++i) x[i] *= rs;
      p[0] = pack8f(x);
      if (r >= MP) { GAS f32x4* o4 = (GAS f32x4*)(out + O_CM + ((size_t)l * MS + (r - MP)) * 512 + lane * 8); o4[0] = (f32x4){x[0], x[1], x[2], x[3]}; o4[1] = (f32x4){x[4], x[5], x[6], x[7]}; } }
    { GAS v4u* p = (GAS v4u*)(prow + C_CU + lane * 8); const v4u a = p[0]; float x[8]; unpack8(a, x);
#pragma unroll
      for (int i = 0; i < 8; ++i) x[i] = gelu_t(x[i]);
      p[0] = pack8f(x); }
}

constexpr int GL_QT = 0;
constexpr int GL_KT = GL_QT + 64 * 68;
constexpr int GL_KD = GL_KT + 64 * 68;
constexpr int GL_AT = GL_KD + 64 * 68;
constexpr int GL_V = GL_AT + 64 * 68;
constexpr int GL_S = GL_V + 64 * 132;
constexpr int GL_D = GL_S + 64 * 132;
static_assert((GL_D + 64) * 4 <= SCR_BYTES, "gla lds");

__device__ __forceinline__ void gla_front(LAS float* L, const bf16* PROJ, int r0, int nrows, int h, const float* __restrict__ w2l, const float* __restrict__ bl, int tid) {
    __syncthreads();
    { const int s = tid >> 3, c = tid & 7; const bool ok = s < nrows; const bf16* prow = PROJ + (size_t)(r0 + s) * NIN;
      { float x[16]; if (ok) { const GAS v4u* p = (const GAS v4u*)(prow + C_GV + h * 128 + c * 16); unpack16(p[0], p[1], x); } else {
#pragma unroll
            for (int i = 0; i < 16; ++i) x[i] = 0.f; }
        LAS f32x4* d = (LAS f32x4*)(L + GL_V + s * 132 + c * 16);
        d[0] = (f32x4){x[0], x[1], x[2], x[3]}; d[1] = (f32x4){x[4], x[5], x[6], x[7]}; d[2] = (f32x4){x[8], x[9], x[10], x[11]}; d[3] = (f32x4){x[12], x[13], x[14], x[15]}; }
      { float acc[8];
#pragma unroll
        for (int i = 0; i < 8; ++i) acc[i] = 0.f;
        if (ok) { float g[16]; { const GAS v4u* p = (const GAS v4u*)(prow + C_LR); unpack16(p[0], p[1], g); }
            const int d0 = h * 64 + c * 8;
#pragma unroll
            for (int i = 0; i < 8; ++i) acc[i] = bl[d0 + i];
#pragma unroll
            for (int j = 0; j < 16; ++j) { const GAS f32x4* w = (const GAS f32x4*)(w2l + j * 256 + d0); const f32x4 w0 = w[0], w1 = w[1];
                acc[0] += g[j] * w0.x; acc[1] += g[j] * w0.y; acc[2] += g[j] * w0.z; acc[3] += g[j] * w0.w; acc[4] += g[j] * w1.x; acc[5] += g[j] * w1.y; acc[6] += g[j] * w1.z; acc[7] += g[j] * w1.w; }
#pragma unroll
            for (int i = 0; i < 8; ++i) acc[i] = logsig_f(acc[i]) * (1.f / 16.f); }
        LAS f32x4* d = (LAS f32x4*)(L + GL_AT + s * 68 + c * 8); d[0] = (f32x4){acc[0], acc[1], acc[2], acc[3]}; d[1] = (f32x4){acc[4], acc[5], acc[6], acc[7]}; } }
    __syncthreads();
    { const int d = tid & 63, sg = tid >> 6; float x[8]; float run = 0.f;
#pragma unroll
      for (int i = 0; i < 8; ++i) { run += L[GL_AT + (sg * 8 + i) * 68 + d]; x[i] = run; }
      L[GL_KD + sg * 64 + d] = run;
      __syncthreads();
      float off = 0.f;
#pragma unroll
      for (int g = 0; g < 8; ++g) { const float t = L[GL_KD + g * 64 + d]; off += (g < sg) ? t : 0.f; }
#pragma unroll
      for (int i = 0; i < 8; ++i) L[GL_AT + (sg * 8 + i) * 68 + d] = x[i] + off; }
    __syncthreads();
    { const int s = tid >> 3, c = tid & 7, d0 = c * 8; const bool ok = s < nrows; const bf16* prow = PROJ + (size_t)(r0 + s) * NIN;
      float q[8], k[8];
      if (ok) { unpack8(*(const GAS v4u*)(prow + C_GQ + h * 64 + d0), q); unpack8(*(const GAS v4u*)(prow + C_GK + h * 64 + d0), k); } else {
#pragma unroll
          for (int i = 0; i < 8; ++i) { q[i] = 0.f; k[i] = 0.f; } }
      const LAS f32x4* cp = (const LAS f32x4*)(L + GL_AT + s * 68 + d0); const LAS f32x4* lp = (const LAS f32x4*)(L + GL_AT + 63 * 68 + d0);
      const f32x4 c0 = cp[0], c1 = cp[1], l0 = lp[0], l1 = lp[1];
      const float cum[8] = {c0.x, c0.y, c0.z, c0.w, c1.x, c1.y, c1.z, c1.w}, last[8] = {l0.x, l0.y, l0.z, l0.w, l1.x, l1.y, l1.z, l1.w};
      float kd[8];
#pragma unroll
      for (int i = 0; i < 8; ++i) { L[GL_QT + (d0 + i) * 68 + s] = q[i] * __expf(cum[i]) * 0.125f; L[GL_KT + (d0 + i) * 68 + s] = k[i] * __expf(-cum[i]); kd[i] = k[i] * __expf(last[i] - cum[i]); }
      __syncthreads();
      LAS f32x4* kp = (LAS f32x4*)(L + GL_KD + s * 68 + d0); kp[0] = (f32x4){kd[0], kd[1], kd[2], kd[3]}; kp[1] = (f32x4){kd[4], kd[5], kd[6], kd[7]};
      if (s == 0) {
#pragma unroll
          for (int i = 0; i < 8; ++i) L[GL_D + d0 + i] = __expf(last[i]); } }
    __syncthreads();
}
__device__ __forceinline__ void gla_U(const LAS float* L, int nrows, int tid, f32x4 (&u)[4]) {
    const int db = tid >> 5, eb = tid & 31;
#pragma unroll
    for (int i = 0; i < 4; ++i) u[i] = (f32x4){0.f, 0.f, 0.f, 0.f};
    for (int s = 0; s < nrows; ++s) { const f32x4 kd4 = *(const LAS f32x4*)(L + GL_KD + s * 68 + 4 * db), v4 = *(const LAS f32x4*)(L + GL_V + s * 132 + 4 * eb);
        u[0] += kd4.x * v4; u[1] += kd4.y * v4; u[2] += kd4.z * v4; u[3] += kd4.w * v4; }
}
__device__ __forceinline__ void gla_prep_item(LAS float* L, const bf16* PROJ, int idx  , const float* w2l, const float* bl, float* GU, float* GD, int tid) {
    const int c = idx & 127, bh = idx >> 7, b = bh >> 2, h = bh & 3;
    gla_front(L, PROJ, b * SEQ + c * 64, 64, h, w2l, bl, tid);
    f32x4 u[4]; gla_U(L, 64, tid, u);
    const int db = tid >> 5, eb = tid & 31;
#pragma unroll
    for (int i = 0; i < 4; ++i) *(GAS f32x4*)(GU + ((size_t)idx * 64 + 4 * db + i) * 128 + 4 * eb) = u[i];
    if (tid < 64) GD[(size_t)idx * 64 + tid] = L[GL_D + tid];
}
__device__ __forceinline__ void gla_mix_item(LAS float* L, const bf16* PROJ, bf16* MIX, int item, int l, KArgs a, const float* GU, const float* GD, int tid) {
    const float* w2l = a->in[10] + (size_t)l * 16 * 256; const float* bl = a->in[11] + (size_t)l * 256; const float* gn = a->in[12] + (size_t)l * 512;
    const int db = tid >> 5, eb = tid & 31;
    const bool samp = item >= 128;
    int h, rbase, nch, nrows, bh = 0, seg = 0, sb = 0;
    f32x4 S[4];
    if (!samp) { seg = 15 - (item >> 3); bh = item & 7; h = bh & 3; rbase = (bh >> 2) * SEQ + seg * 512; nch = 8; nrows = 64;
#pragma unroll
        for (int i = 0; i < 4; ++i) S[i] = (f32x4){0.f, 0.f, 0.f, 0.f};
        const int n0 = seg * 8;
#pragma unroll 4
        for (int cc = 0; cc < n0; ++cc) { const size_t idx = (size_t)bh * 128 + cc; const f32x4 d4 = *(const GAS f32x4*)(GD + idx * 64 + 4 * db);
            const GAS float* up = (const GAS float*)(GU + (idx * 64 + 4 * db) * 128 + 4 * eb);
            const f32x4 u0 = *(const GAS f32x4*)(up), u1 = *(const GAS f32x4*)(up + 128), u2 = *(const GAS f32x4*)(up + 256), u3 = *(const GAS f32x4*)(up + 384);
            S[0] = d4.x * S[0] + u0; S[1] = d4.y * S[1] + u1; S[2] = d4.z * S[2] + u2; S[3] = d4.w * S[3] + u3; } }
    else { const int si = item - 128; sb = si >> 2; h = si & 3; rbase = MP + sb * DECS; nch = 1; nrows = DECS;
        const float* s0 = a->in[4] + (((size_t)l * DECB + sb) * 4 + h) * 8192;
#pragma unroll
        for (int i = 0; i < 4; ++i) S[i] = *(const GAS f32x4*)(s0 + (4 * db + i) * 128 + 4 * eb); }
    for (int c = 0; c < nch; ++c) {
        const int r0 = rbase + c * 64;
        gla_front(L, PROJ, r0, nrows, h, w2l, bl, tid);
        f32x4 u[4]; gla_U(L, nrows, tid, u);
        { const int tb2 = tid >> 4, sb4 = tid & 15; f32x4 o0 = {0.f, 0.f, 0.f, 0.f}, o1 = {0.f, 0.f, 0.f, 0.f};
          for (int d = 0; d < 64; ++d) { const f32x2 q2 = *(const LAS f32x2*)(L + GL_QT + d * 68 + 2 * tb2); const f32x4 k4 = *(const LAS f32x4*)(L + GL_KT + d * 68 + 4 * sb4); o0 += q2.x * k4; o1 += q2.y * k4; }
          const int t0 = 2 * tb2, s0 = 4 * sb4;
#pragma unroll
          for (int j = 0; j < 4; ++j) { L[GL_AT + (s0 + j) * 68 + t0] = (s0 + j <= t0) ? o0[j] : 0.f; L[GL_AT + (s0 + j) * 68 + t0 + 1] = (s0 + j <= t0 + 1) ? o1[j] : 0.f; } }
#pragma unroll
        for (int i = 0; i < 4; ++i) *(LAS f32x4*)(L + GL_S + (4 * db + i) * 132 + 4 * eb) = S[i];
        __syncthreads();
        { const int tb = db; f32x4 acc[4];
#pragma unroll
          for (int i = 0; i < 4; ++i) acc[i] = (f32x4){0.f, 0.f, 0.f, 0.f};
          const int smax = nrows < 64 ? nrows : 64;
          for (int s = 0; s < smax; ++s) { const f32x4 a4 = *(const LAS f32x4*)(L + GL_AT + s * 68 + 4 * tb), v4 = *(const LAS f32x4*)(L + GL_V + s * 132 + 4 * eb);
              acc[0] += a4.x * v4; acc[1] += a4.y * v4; acc[2] += a4.z * v4; acc[3] += a4.w * v4; }
          for (int d = 0; d < 64; ++d) { const f32x4 q4 = *(const LAS f32x4*)(L + GL_QT + d * 68 + 4 * tb), s4 = *(const LAS f32x4*)(L + GL_S + d * 132 + 4 * eb);
              acc[0] += q4.x * s4; acc[1] += q4.y * s4; acc[2] += q4.z * s4; acc[3] += q4.w * s4; }
          const f32x4 g4 = *(const GAS f32x4*)(gn + h * 128 + 4 * eb);
#pragma unroll
          for (int i = 0; i < 4; ++i) { const int t = 4 * tb + i; float ss = (acc[i].x * acc[i].x + acc[i].y * acc[i].y) + (acc[i].z * acc[i].z + acc[i].w * acc[i].w);
              ss += shx<1>(ss); ss += shx<2>(ss); ss += shx<4>(ss); ss += shx<8>(ss); ss += shx<16>(ss);
              const float rs = rsqrtf(ss * (1.f / 128.f) + EPS);
              if (t < nrows) { const u32x2 gr = *(const GAS u32x2*)(PROJ + (size_t)(r0 + t) * NIN + C_GR + h * 128 + 4 * eb);
                  const float y0 = acc[i].x * rs * g4.x * silu_f(bf_lo(gr.x)), y1 = acc[i].y * rs * g4.y * silu_f(bf_hi(gr.x)), y2 = acc[i].z * rs * g4.z * silu_f(bf_lo(gr.y)), y3 = acc[i].w * rs * g4.w * silu_f(bf_hi(gr.y));
                  u32x2 w; w.x = pkbf(y0, y1); w.y = pkbf(y2, y3); *(GAS u32x2*)(MIX + (size_t)(r0 + t) * DM + 512 + h * 128 + 4 * eb) = w; } } }
        { const f32x4 d4 = *(const LAS f32x4*)(L + GL_D + 4 * db); S[0] = d4.x * S[0] + u[0]; S[1] = d4.y * S[1] + u[1]; S[2] = d4.z * S[2] + u[2]; S[3] = d4.w * S[3] + u[3]; }
    }
    if (samp) { float* so = a->out + O_GS + (((size_t)l * DECB + sb) * 4 + h) * 8192;
#pragma unroll
        for (int i = 0; i < 4; ++i) *(GAS f32x4*)(so + (4 * db + i) * 128 + 4 * eb) = S[i]; }
    else if (seg == 15) { float* so = a->out + O_GP + ((size_t)l * 8 + bh) * 8192;
#pragma unroll
        for (int i = 0; i < 4; ++i) *(GAS f32x4*)(so + (4 * db + i) * 128 + 4 * eb) = S[i]; }
}

constexpr int CM_VN = 0;
constexpr int CM_WT = 128 * 132;
static_assert((CM_WT + 128 * 68) * 4 <= SCR_BYTES, "cm lds");
__device__ __forceinline__ void cm_item(LAS float* L, const bf16* PROJ, bf16* MIX, int item, int l, KArgs a, int tid) {
    int r0, g, nrows;
    if (item < 512) { g = item & 3; const int bn = item >> 2; r0 = (bn >> 6) * SEQ + (bn & 63) * 128; nrows = 128; }
    else { const int si = item - 512; g = si & 3; r0 = MP + (si >> 2) * DECS; nrows = DECS; }
    const float* Wg = a->in[8] + ((size_t)l * 4 + g) * 128 * 128; const float* bg = a->in[9] + ((size_t)l * 4 + g) * 128;
    __syncthreads();
    { const int j = tid >> 2, c0 = (tid & 3) * 32; float x[16], y[16];
      if (j < nrows) { const GAS v4u* p = (const GAS v4u*)(PROJ + (size_t)(r0 + j) * NIN + C_CV + g * 128 + c0); unpack16(p[0], p[1], x); unpack16(p[2], p[3], y); } else {
#pragma unroll
          for (int i = 0; i < 16; ++i) { x[i] = 0.f; y[i] = 0.f; } }
      LAS f32x4* d = (LAS f32x4*)(L + CM_VN + j * 132 + c0);
#pragma unroll
      for (int i = 0; i < 4; ++i) { d[i] = (f32x4){x[4 * i], x[4 * i + 1], x[4 * i + 2], x[4 * i + 3]}; d[4 + i] = (f32x4){y[4 * i], y[4 * i + 1], y[4 * i + 2], y[4 * i + 3]}; } }
    const int ib = tid >> 5, cb = tid & 31;
    for (int half = 0; half < 2; ++half) {
        if (half * 64 >= nrows) break;
        __syncthreads();
#pragma unroll 4
        for (int e = tid; e < 64 * 128; e += NTHR) { const int i = e >> 7, j = e & 127; L[CM_WT + j * 68 + i] = Wg[(size_t)(half * 64 + i) * 128 + j]; }
        __syncthreads();
        int jmax = half ? 128 : 64; if (jmax > nrows) jmax = nrows;
        f32x4 acc[4];
#pragma unroll
        for (int i = 0; i < 4; ++i) acc[i] = (f32x4){0.f, 0.f, 0.f, 0.f};
        for (int j = 0; j < jmax; ++j) { const f32x4 w4 = *(const LAS f32x4*)(L + CM_WT + j * 68 + 4 * ib), v4 = *(const LAS f32x4*)(L + CM_VN + j * 132 + 4 * cb);
            acc[0] += w4.x * v4; acc[1] += w4.y * v4; acc[2] += w4.z * v4; acc[3] += w4.w * v4; }
#pragma unroll
        for (int i = 0; i < 4; ++i) { const int ii = half * 64 + 4 * ib + i;
            if (ii < nrows) { const float bb = bg[ii]; const u32x2 uu = *(const GAS u32x2*)(PROJ + (size_t)(r0 + ii) * NIN + C_CU + g * 128 + 4 * cb);
                u32x2 w; w.x = pkbf(bf_lo(uu.x) * (acc[i].x + bb), bf_hi(uu.x) * (acc[i].y + bb)); w.y = pkbf(bf_lo(uu.y) * (acc[i].z + bb), bf_hi(uu.y) * (acc[i].w + bb));
                *(GAS u32x2*)(MIX + (size_t)(r0 + ii) * DM + g * 128 + 4 * cb) = w; } }
    }
}

constexpr int SA_Q = 0, SA_K = 16 * 128, SA_V = SA_K + 64 * 132, SA_A = SA_V + 64 * 132;
static_assert((SA_A + 16 * 64) * 4 <= SCR_BYTES, "sa lds");
__device__ __forceinline__ float sfx32(float x, int j, int lane) {
#pragma unroll
    for (int o = 1; o < 32; o <<= 1) { const float y = bperm(x, lane + o); x *= (j + o < 32) ? y : 1.f; }
    return x;
}
__device__ __forceinline__ void sattn_item(LAS float* L, const bf16* PROJ, bf16* MIX, int item, int l, KArgs a, int tid) {
    const int sb = item >> 3, h = item & 7, rq = MP + sb * DECS;
    const int i = tid >> 5, j = tid & 31;
    __syncthreads();
    { const int qi = tid >> 5, d4 = (tid & 31) * 4; const u32x2 w = *(const GAS u32x2*)(PROJ + (size_t)(rq + qi) * NIN + C_SQ + h * 128 + d4);
      *(LAS f32x4*)(L + SA_Q + qi * 128 + d4) = (f32x4){bf_lo(w.x), bf_hi(w.x), bf_lo(w.y), bf_hi(w.y)}; }
    f32x4 o = {0.f, 0.f, 0.f, 0.f}; float carry = 1.f;
    const float* ck = a->in[2] + ((size_t)l * DECB + sb) * PAST * 1024 + h * 128; const float* cv = a->in[3] + ((size_t)l * DECB + sb) * PAST * 1024 + h * 128;
    for (int blk = 32; blk >= 0; --blk) {
        __syncthreads();
        { const int key = tid >> 3, c = tid & 7;
          if (blk == 32) {
              float kx[16], vx[16];
              if (key < DECS) { const bf16* prow = PROJ + (size_t)(rq + key) * NIN + h * 128 + c * 16; const GAS v4u* pk = (const GAS v4u*)(prow + C_SK); const GAS v4u* pv = (const GAS v4u*)(prow + C_SV);
                  unpack16(pk[0], pk[1], kx); unpack16(pv[0], pv[1], vx); } else {
#pragma unroll
                  for (int t = 0; t < 16; ++t) { kx[t] = 0.f; vx[t] = 0.f; } }
              LAS f32x4* dk = (LAS f32x4*)(L + SA_K + key * 132 + c * 16); LAS f32x4* dv = (LAS f32x4*)(L + SA_V + key * 132 + c * 16);
#pragma unroll
              for (int t = 0; t < 4; ++t) { dk[t] = (f32x4){kx[4 * t], kx[4 * t + 1], kx[4 * t + 2], kx[4 * t + 3]}; dv[t] = (f32x4){vx[4 * t], vx[4 * t + 1], vx[4 * t + 2], vx[4 * t + 3]}; }
          } else {
              const size_t off = (size_t)(blk * 64 + key) * 1024;
#pragma unroll
              for (int t = 0; t < 4; ++t) { const int d = t * 32 + c * 4;
                  *(LAS f32x4*)(L + SA_K + key * 132 + d) = *(const GAS f32x4*)(ck + off + d); *(LAS f32x4*)(L + SA_V + key * 132 + d) = *(const GAS f32x4*)(cv + off + d); }
          } }
        __syncthreads();
        float zl = 0.f, zh = 0.f;
        { const LAS f32x4* q4 = (const LAS f32x4*)(L + SA_Q + i * 128); const LAS f32x4* kl = (const LAS f32x4*)(L + SA_K + j * 132); const LAS f32x4* kh = (const LAS f32x4*)(L + SA_K + (j + 32) * 132);
#pragma unroll 8
          for (int d = 0; d < 32; ++d) { const f32x4 q = q4[d], x = kl[d], y = kh[d]; zl += (q.x * x.x + q.y * x.y) + (q.z * x.z + q.w * x.w); zh += (q.x * y.x + q.y * y.y) + (q.z * y.z + q.w * y.w); } }
        const bool vl = (blk < 32) || (j < i), vh = (blk < 32);
        const float el = __builtin_amdgcn_exp2f(zl), eh = __builtin_amdgcn_exp2f(zh), rl = 1.f / (1.f + el), rh = 1.f / (1.f + eh);
        const float stl = vl ? rl : 1.f, sth = vh ? rh : 1.f, bl_ = vl ? el * rl : 0.f, bh_ = vh ? eh * rh : 0.f;
        const int lane = tid & 63; const float xh = sfx32(sth, j, lane), xl = sfx32(stl, j, lane);
        float eh_x = bperm(xh, lane + 1); eh_x = (j < 31) ? eh_x : 1.f;
        float el_x = bperm(xl, lane + 1); el_x = (j < 31) ? el_x : 1.f;
        const float totH = bperm(xh, lane & 32), totL = bperm(xl, lane & 32);
        L[SA_A + i * 64 + 32 + j] = bh_ * eh_x * carry;
        L[SA_A + i * 64 + j] = bl_ * el_x * totH * carry;
        carry = carry * totH * totL;
        __syncthreads();
        { const int d4 = j * 4; const LAS float* ap = L + SA_A + i * 64;
#pragma unroll 8
          for (int s = 0; s < 64; ++s) { const float p = ap[s]; const f32x4 v4 = *(const LAS f32x4*)(L + SA_V + s * 132 + d4); o += p * v4; } }
    }
    { u32x2 w; w.x = pkbf(o.x, o.y); w.y = pkbf(o.z, o.w); *(GAS u32x2*)(MIX + (size_t)(rq + i) * DM + 1024 + h * 128 + j * 4) = w; }
}

namespace att {
typedef short s16x4 __attribute__((ext_vector_type(4)));
typedef float f32x16 __attribute__((ext_vector_type(16)));
constexpr int SHM_V = 64 * 128 * 2, SHM_K = 64 * 128 * 2;
#define KSWZ(row, colB) ((row) * 256 + ((colB) ^ (((row) & 7) << 4)))
#define SBAR() __builtin_amdgcn_sched_barrier(0)
__device__ __forceinline__ int v_st(int k, int c) { const int kk = (k & ~0xC) | ((k & 4) << 1) | ((k & 8) >> 1); return ((kk >> 3) * 4 + (c >> 5)) * 512 + ((kk & 7) * 32 + (c & 31)) * 2; }
__device__ __forceinline__ int v_rd_base(int lane) { return ((lane & 3) << 3) | (((lane >> 2) & 3) << 6) | (((lane >> 4) & 1) << 5) | (((lane >> 5) & 1) << 8); }
constexpr int v_rd_off(int d0, int ks, int half) { return d0 * 512 + ks * 4096 + half * 2048; }
__device__ __forceinline__ int crow(int r, int hi) { return (r & 3) + 8 * (r >> 2) + 4 * hi; }
__device__ __forceinline__ void qkt(f32x16& p0, f32x16& p1, const char* K_lds, int r32, int hi, const bf16x8* qr) {
    p0 = f32x16{}; p1 = f32x16{};
    const char* kb[4];
#pragma unroll
    for (int dd = 0; dd < 4; ++dd) kb[dd] = K_lds + KSWZ(r32, (dd * 16 + hi * 8) * 2);
#pragma unroll
    for (int d0 = 0; d0 < 8; ++d0) { const char* a = kb[d0 & 3] + (d0 >> 2) * 128;
        bf16x8 b0 = *reinterpret_cast<const bf16x8*>(a);
        bf16x8 b1 = *reinterpret_cast<const bf16x8*>(a + 32 * 256);
        p0 = __builtin_amdgcn_mfma_f32_32x32x16_bf16(b0, qr[d0], p0, 0, 0, 0);
        p1 = __builtin_amdgcn_mfma_f32_32x32x16_bf16(b1, qr[d0], p1, 0, 0, 0); }
}
__device__ __forceinline__ void pv_tile(f32x16* o, int vb0, bf16x8 pa0, bf16x8 pa1, bf16x8 pa2, bf16x8 pa3) {
#define TRRD(dst, off) asm volatile("ds_read_b64_tr_b16 %0, %1 offset:%2" : "=&v"(dst) : "v"(vb0), "i"(off) : "memory")
#define PV_D0(d0) do { s16x4 l0, l1, l2, l3, h0, h1, h2, h3; constexpr int b_ = v_rd_off(d0, 0, 0); \
        TRRD(l0, b_); TRRD(h0, b_ + 2048); TRRD(l1, b_ + 4096); TRRD(h1, b_ + 6144); TRRD(l2, b_ + 8192); TRRD(h2, b_ + 10240); TRRD(l3, b_ + 12288); TRRD(h3, b_ + 14336); \
        asm volatile("s_waitcnt lgkmcnt(0)" ::: "memory"); SBAR(); \
        o[d0] = __builtin_amdgcn_mfma_f32_32x32x16_bf16(pa0, (bf16x8){l0[0], l0[1], l0[2], l0[3], h0[0], h0[1], h0[2], h0[3]}, o[d0], 0, 0, 0); \
        o[d0] = __builtin_amdgcn_mfma_f32_32x32x16_bf16(pa1, (bf16x8){l1[0], l1[1], l1[2], l1[3], h1[0], h1[1], h1[2], h1[3]}, o[d0], 0, 0, 0); \
        o[d0] = __builtin_amdgcn_mfma_f32_32x32x16_bf16(pa2, (bf16x8){l2[0], l2[1], l2[2], l2[3], h2[0], h2[1], h2[2], h2[3]}, o[d0], 0, 0, 0); \
        o[d0] = __builtin_amdgcn_mfma_f32_32x32x16_bf16(pa3, (bf16x8){l3[0], l3[1], l3[2], l3[3], h3[0], h3[1], h3[2], h3[3]}, o[d0], 0, 0, 0); } while (0)
    PV_D0(0); PV_D0(1); PV_D0(2); PV_D0(3);
#undef PV_D0
#undef TRRD
}
template <bool MASK>
__device__ __forceinline__ void sb_tile(f32x16& p0, f32x16& p1, float& carry, int hi, int dq  ) {
    float st0[16], st1[16];
#pragma unroll
    for (int r = 0; r < 16; ++r) { const int c = (r & 3) + 8 * (r >> 2);
        { const float e = __builtin_amdgcn_exp2f(p0[r]), rr = __builtin_amdgcn_rcpf(1.f + e); const bool v = !MASK || (c < dq); p0[r] = v ? e * rr : 0.f; st0[r] = v ? rr : 1.f; }
        { const float e = __builtin_amdgcn_exp2f(p1[r]), rr = __builtin_amdgcn_rcpf(1.f + e); const bool v = !MASK || (c + 32 < dq); p1[r] = v ? e * rr : 0.f; st1[r] = v ? rr : 1.f; } }
    float pp[8], pt[8];
#pragma unroll
    for (int k = 0; k < 4; ++k) {
        { const float g = (st0[4 * k] * st0[4 * k + 1]) * (st0[4 * k + 2] * st0[4 * k + 3]); auto rr = __builtin_amdgcn_permlane32_swap(__float_as_uint(g), __float_as_uint(g), false, false);
          const float r0 = __uint_as_float(rr[0]), r1 = __uint_as_float(rr[1]); pp[k] = r0 * r1; pt[k] = hi ? 1.f : r1; }
        { const float g = (st1[4 * k] * st1[4 * k + 1]) * (st1[4 * k + 2] * st1[4 * k + 3]); auto rr = __builtin_amdgcn_permlane32_swap(__float_as_uint(g), __float_as_uint(g), false, false);
          const float r0 = __uint_as_float(rr[0]), r1 = __uint_as_float(rr[1]); pp[4 + k] = r0 * r1; pt[4 + k] = hi ? 1.f : r1; } }
    float pe = carry;
#pragma unroll
    for (int k = 7; k >= 0; --k) { float x = pe * pt[k]; pe *= pp[k];
        if (k >= 4) { const int b = 4 * (k - 4); p1[b + 3] *= x; x *= st1[b + 3]; p1[b + 2] *= x; x *= st1[b + 2]; p1[b + 1] *= x; x *= st1[b + 1]; p1[b] *= x; }
        else { const int b = 4 * k; p0[b + 3] *= x; x *= st0[b + 3]; p0[b + 2] *= x; x *= st0[b + 2]; p0[b + 1] *= x; x *= st0[b + 1]; p0[b] *= x; } }
    carry = pe;
}
#define PK4(P, B_, OUT) do { unsigned a0 = pkbf(P[B_ + 0], P[B_ + 1]), a1 = pkbf(P[B_ + 2], P[B_ + 3]); \
        unsigned b0 = pkbf(P[B_ + 4], P[B_ + 5]), b1 = pkbf(P[B_ + 6], P[B_ + 7]); \
        auto r0 = __builtin_amdgcn_permlane32_swap(a0, b0, false, false); auto r1 = __builtin_amdgcn_permlane32_swap(a1, b1, false, false); \
        v4u w = {r0[0], r1[0], r0[1], r1[1]}; OUT = *reinterpret_cast<bf16x8*>(&w); } while (0)

__device__ __forceinline__ void attn_item(char* lds, const bf16* PROJ, bf16* MIX, int b, int h, int qb, int tid) {
    const int wid = __builtin_amdgcn_readfirstlane(tid >> 6), lane = tid & 63, r32 = lane & 31, hi = lane >> 5;
    char* V_lds = lds; char* K_lds = lds + 2 * SHM_V;
    const int P0 = qb * 256, rowbase = b * SEQ, qlo = P0 + wid * 32, qpos = qlo + r32;
    bf16x8 qr[8];
    { const bf16* qp = PROJ + (size_t)(rowbase + qpos) * NIN + C_SQ + h * 128 + hi * 8;
#pragma unroll
      for (int d0 = 0; d0 < 8; ++d0) qr[d0] = *reinterpret_cast<const bf16x8*>(qp + d0 * 16); }
    f32x16 o[4] = {};
    float carry = 1.f;
    const int sr = tid >> 4, sc = (tid & 15) * 8, vst0 = v_st(sr, sc), vst1 = v_st(32 + sr, sc), kws = KSWZ(sr, sc * 2);
    const int vb0 = (int)(uintptr_t)V_lds + v_rd_base(lane);
    for (int jt = 4 * qb + 3; jt >= 0; --jt) {
        const int kb0 = jt * 64;
        __syncthreads();
        { const bf16* kp = PROJ + (size_t)(rowbase + kb0 + sr) * NIN + C_SK + h * 128 + sc;
          const bf16x8 k0 = *reinterpret_cast<const bf16x8*>(kp), k1 = *reinterpret_cast<const bf16x8*>(kp + (size_t)32 * NIN);
          const bf16x8 v0 = *reinterpret_cast<const bf16x8*>(kp + (C_SV - C_SK)), v1 = *reinterpret_cast<const bf16x8*>(kp + (size_t)32 * NIN + (C_SV - C_SK));
          *(bf16x8*)(K_lds + kws) = k0; *(bf16x8*)(K_lds + kws + 32 * 256) = k1; *(bf16x8*)(V_lds + vst0) = v0; *(bf16x8*)(V_lds + vst1) = v1; }
        __syncthreads();
        if (kb0 < qlo + 31) {
            f32x16 p0, p1;
            qkt(p0, p1, K_lds, r32, hi, qr);
            if (kb0 + 63 >= qlo) sb_tile<true>(p0, p1, carry, hi, qpos - kb0 - 4 * hi); else sb_tile<false>(p0, p1, carry, hi, 0);
            bf16x8 pa0, pa1, pa2, pa3;
            PK4(p0, 0, pa0); PK4(p0, 8, pa1); PK4(p1, 0, pa2); PK4(p1, 8, pa3);
            pv_tile(o, vb0, pa0, pa1, pa2, pa3);
        }
    }
    bf16* Ow = MIX + (size_t)(rowbase + qlo) * DM + 1024 + h * 128;
#pragma unroll
    for (int r = 0; r < 16; ++r) { const int orow = crow(r, hi);
#pragma unroll
        for (int d0 = 0; d0 < 4; ++d0) { const float v = o[d0][r]; const float vn = shx<1>(v);
            if ((r32 & 1) == 0) *(unsigned*)(Ow + (size_t)orow * DM + d0 * 32 + r32) = pkbf(v, vn); } }
}
#undef PK4
#undef KSWZ
#undef SBAR
}

__device__ __forceinline__ void conv_phase(const bf16* GU, bf16* HID, int l, KArgs a, int gtid, int GT) {
    const float* cw = a->in[19] + (size_t)l * 3 * FF; const float* cb = a->in[20] + (size_t)l * FF;
    constexpr int NF8 = FF / 8;
    for (int idx = gtid; idx < MR * NF8; idx += GT) {
        const int r = idx / NF8, f = (idx - r * NF8) * 8;
        const int col = (f >> 7) * 256 + (f & 127);
        const bf16* gp = GU + (size_t)r * NGU + col;
        float g0[8], g1[8], g2[8], uu[8];
        unpack8(*(const GAS v4u*)gp, g2); unpack8(*(const GAS v4u*)(gp + 128), uu);
        int t; if (r < MP) t = r & (SEQ - 1); else t = (r - MP) & (DECS - 1);
        if (r < MP) {
            if (t >= 1) unpack8(*(const GAS v4u*)(gp - NGU), g1); else {
#pragma unroll
                for (int i = 0; i < 8; ++i) g1[i] = 0.f; }
            if (t >= 2) unpack8(*(const GAS v4u*)(gp - 2 * (size_t)NGU), g0); else {
#pragma unroll
                for (int i = 0; i < 8; ++i) g0[i] = 0.f; }
        } else {
            const int sb = (r - MP) >> 4; const float* st = a->in[5] + ((size_t)l * DECB + sb) * 2 * FF + f;
            if (t >= 1) unpack8(*(const GAS v4u*)(gp - NGU), g1); else { const f32x4 x = *(const GAS f32x4*)(st + FF), y = *(const GAS f32x4*)(st + FF + 4);
                g1[0] = x.x; g1[1] = x.y; g1[2] = x.z; g1[3] = x.w; g1[4] = y.x; g1[5] = y.y; g1[6] = y.z; g1[7] = y.w; }
            if (t >= 2) unpack8(*(const GAS v4u*)(gp - 2 * (size_t)NGU), g0); else { const float* s2 = st + (t == 0 ? 0 : FF); const f32x4 x = *(const GAS f32x4*)(s2), y = *(const GAS f32x4*)(s2 + 4);
                g0[0] = x.x; g0[1] = x.y; g0[2] = x.z; g0[3] = x.w; g0[4] = y.x; g0[5] = y.y; g0[6] = y.z; g0[7] = y.w; }
        }
        float w0[8], w1[8], w2[8], bb[8];
        { const GAS f32x4* p = (const GAS f32x4*)(cw + f); const f32x4 x = p[0], y = p[1]; w0[0] = x.x; w0[1] = x.y; w0[2] = x.z; w0[3] = x.w; w0[4] = y.x; w0[5] = y.y; w0[6] = y.z; w0[7] = y.w; }
        { const GAS f32x4* p = (const GAS f32x4*)(cw + FF + f); const f32x4 x = p[0], y = p[1]; w1[0] = x.x; w1[1] = x.y; w1[2] = x.z; w1[3] = x.w; w1[4] = y.x; w1[5] = y.y; w1[6] = y.z; w1[7] = y.w; }
        { const GAS f32x4* p = (const GAS f32x4*)(cw + 2 * FF + f); const f32x4 x = p[0], y = p[1]; w2[0] = x.x; w2[1] = x.y; w2[2] = x.z; w2[3] = x.w; w2[4] = y.x; w2[5] = y.y; w2[6] = y.z; w2[7] = y.w; }
        { const GAS f32x4* p = (const GAS f32x4*)(cb + f); const f32x4 x = p[0], y = p[1]; bb[0] = x.x; bb[1] = x.y; bb[2] = x.z; bb[3] = x.w; bb[4] = y.x; bb[5] = y.y; bb[6] = y.z; bb[7] = y.w; }
        float hv[8];
#pragma unroll
        for (int i = 0; i < 8; ++i) { const float g = bb[i] + w0[i] * g0[i] + w1[i] * g1[i] + w2[i] * g2[i]; hv[i] = silu_f(g) * uu[i]; }
        *(GAS v4u*)(HID + (size_t)r * FF + f) = pack8f(hv);
        float* cs = nullptr;
        if (r < MP) { if (t == SEQ - 1) cs = a->out + O_CP + ((size_t)l * NBATCH + (r >> 13)) * 2 * FF + f; }
        else { if (t == DECS - 1) cs = a->out + O_CS + ((size_t)l * DECB + ((r - MP) >> 4)) * 2 * FF + f; }
        if (cs) { *(GAS f32x4*)(cs) = (f32x4){g1[0], g1[1], g1[2], g1[3]}; *(GAS f32x4*)(cs + 4) = (f32x4){g1[4], g1[5], g1[6], g1[7]};
                  *(GAS f32x4*)(cs + FF) = (f32x4){g2[0], g2[1], g2[2], g2[3]}; *(GAS f32x4*)(cs + FF + 4) = (f32x4){g2[4], g2[5], g2[6], g2[7]}; }
    }
}

#define PH_IDS() const int tid = fresh_tid(), lane = tid & 63, wave = __builtin_amdgcn_readfirstlane(tid >> 6); const int bx = fresh_bx(), G = gridDim.x; \
    const int vcu = (G % 8 == 0) ? (bx % 8) * (G / 8) + bx / 8 : bx; const int gw = vcu * NWAVES + wave, NGW = G * NWAVES, gtid = bx * NTHR + tid, GT = G * NTHR; \
    KArgs a = kargs(); unsigned char* ws = a->ws; (void)lane; (void)gw; (void)NGW; (void)gtid; (void)GT; (void)ws
#define GRID_BAR() do { KArgs a_ = kargs(); XcdBarrier b_; b_.bar = (unsigned*)(a_->ws + WS_CTL) + CW_BAR; b_.x = xb_xcc_id(); b_.st = (volatile LAS unsigned*)(lds + LCTL_OFF) + 8; xcd_barrier(b_); } while (0)
__global__ void __launch_bounds__(NTHR, 2) fwd(Args a_unused) {
    extern __shared__ __attribute__((aligned(16))) unsigned char lds_raw[];
    LAS unsigned char* lds = (LAS unsigned char*)lds_raw;
    { volatile LAS unsigned* LC = (volatile LAS unsigned*)(lds + LCTL_OFF);
      if (threadIdx.x < 64) LC[threadIdx.x] = 0u;
      __syncthreads();
      KArgs a = kargs();
      (void)xcd_barrier_post((unsigned*)(a->ws + WS_CTL) + CW_BAR, LC + 8); }

    { PH_IDS(); asm volatile("; MARK_PHASE_1" ::: "memory"); p0_prologue(a, lds, gw, NGW, wave, lane, gtid, GT); }
    GRID_BAR();

    for (int l = 0; l < NL; ++l) {
        { PH_IDS(); asm volatile("; MARK_PHASE_2" ::: "memory"); norm_phase(a->out, a->in[6] + (size_t)l * DM, (bf16*)(ws + WS_H), gw, NGW, lane); }
        GRID_BAR();
        { PH_IDS(); asm volatile("; MARK_PHASE_3" ::: "memory"); pg8::Gemm g{(const bf16*)(ws + WS_H), (const bf16*)(ws + WS_W + (size_t)l * SZ_WL), MT, NIN, DM}; pg8::StaticOrder S; S.init(MT, NIN, G, bx);
          pg8::EpiBf16<0> E{(bf16*)(ws + WS_PROJ), NIN, nullptr, 0, 0, 1.f};
          pg8::gemm_phase<pg8::EpiBf16<0>, pg8::StaticOrder, true, true>(lds, g, S, E); }
        GRID_BAR();
        { PH_IDS(); asm volatile("; MARK_PHASE_4" ::: "memory"); bf16* PROJ = (bf16*)(ws + WS_PROJ);
          { const float* gq = a->in[13] + (size_t)l * 128; const float* gk = a->in[14] + (size_t)l * 128;
            for (int r = gw; r < MR; r += NGW) prep_row(PROJ, r, l, gq, gk, a->out, fresh_tid() & 63); }
          { const float* w2l = a->in[10] + (size_t)l * 16 * 256; const float* bl = a->in[11] + (size_t)l * 256;
            for (int it = bx; it < 1024; it += G) gla_prep_item((LAS float*)lds, PROJ, it, w2l, bl, (float*)(ws + WS_GLAU), (float*)(ws + WS_GLAD), fresh_tid()); } }
        GRID_BAR();
        { PH_IDS(); asm volatile("; MARK_PHASE_5" ::: "memory"); bf16* PROJ = (bf16*)(ws + WS_PROJ); bf16* MIX = (bf16*)(ws + WS_MIX);
          volatile LAS unsigned* LC = (volatile LAS unsigned*)(lds + LCTL_OFF);
          unsigned* qctr = (unsigned*)(ws + WS_CTL) + CW_Q + 64 * l;
          for (;;) {
              __syncthreads();
              if (tid == 0) LC[0] = __hip_atomic_fetch_add(qctr, 1u, __ATOMIC_RELAXED, __HIP_MEMORY_SCOPE_AGENT);
              __syncthreads();
              const int it = (int)LC[0];
              if (it >= 1280) break;
              if (it < 160) { asm volatile("; MARK_ITEM_GLA" ::: "memory"); gla_mix_item((LAS float*)lds, PROJ, MIX, it, l, a, (const float*)(ws + WS_GLAU), (const float*)(ws + WS_GLAD), fresh_tid()); }
              else if (it < 672) { asm volatile("; MARK_ITEM_ATT" ::: "memory"); const int i2 = it - 160; att::attn_item((char*)lds_raw, PROJ, MIX, (i2 & 15) >> 3, i2 & 7, 31 - (i2 >> 4), fresh_tid()); }
              else if (it < 736) { asm volatile("; MARK_ITEM_SATT" ::: "memory"); sattn_item((LAS float*)lds, PROJ, MIX, it - 672, l, a, fresh_tid()); }
              else { asm volatile("; MARK_ITEM_CM" ::: "memory"); cm_item((LAS float*)lds, PROJ, MIX, it - 736, l, a, fresh_tid()); }
          } }
        GRID_BAR();
        { PH_IDS(); asm volatile("; MARK_PHASE_6" ::: "memory"); pg8::Gemm g{(const bf16*)(ws + WS_MIX), (const bf16*)(ws + WS_W + (size_t)l * SZ_WL + SZ_WIN), MT, DM, DM}; pg8::StaticOrder S; S.init(MT, DM, G, bx);
          pg8::EpiResF32 E{a->out, DM, MR};
          pg8::gemm_phase<pg8::EpiResF32, pg8::StaticOrder, true, true>(lds, g, S, E); }
        GRID_BAR();
        { PH_IDS(); asm volatile("; MARK_PHASE_7" ::: "memory"); norm_phase(a->out, a->in[16] + (size_t)l * DM, (bf16*)(ws + WS_H), gw, NGW, lane); }
        GRID_BAR();
        { PH_IDS(); asm volatile("; MARK_PHASE_8" ::: "memory"); pg8::Gemm g{(const bf16*)(ws + WS_H), (const bf16*)(ws + WS_W + (size_t)l * SZ_WL + SZ_WIN + SZ_WOUT), MT, NGU, DM}; pg8::StaticOrder S; S.init(MT, NGU, G, bx);
          pg8::EpiBf16<0> E{(bf16*)(ws + WS_GU), NGU, nullptr, 0, 0, 1.f};
          pg8::gemm_phase<pg8::EpiBf16<0>, pg8::StaticOrder, true, true>(lds, g, S, E); }
        GRID_BAR();
        { PH_IDS(); asm volatile("; MARK_PHASE_9" ::: "memory"); conv_phase((const bf16*)(ws + WS_GU), (bf16*)(ws + WS_HID), l, a, gtid, GT); }
        GRID_BAR();
        { PH_IDS(); asm volatile("; MARK_PHASE_10" ::: "memory"); pg8::Gemm g{(const bf16*)(ws + WS_HID), (const bf16*)(ws + WS_W + (size_t)l * SZ_WL + SZ_WIN + SZ_WOUT + SZ_WGU), MT, DM, FF}; pg8::StaticOrder S; S.init(MT, DM, G, bx);
          pg8::EpiResF32 E{a->out, DM, MR};
          pg8::gemm_phase<pg8::EpiResF32, pg8::StaticOrder, true, true>(lds, g, S, E); }
        GRID_BAR();
    }
}

extern "C" void kernel_launch(void* const* d_in, const int* in_sizes, int n_in, void* d_out, int out_size, void* d_ws, size_t ws_size, hipStream_t stream) {
    static int grid = 0;
    if (grid == 0) {
        if (n_in != 22 || (size_t)out_size != O_END || ws_size < WS_END) { fprintf(stderr, "kernel_launch: unexpected shapes (n_in %d, out %d want %zu, ws %zu want >= %zu); nothing launched\n", n_in, out_size, (size_t)O_END, ws_size, (size_t)WS_END); grid = -1; return; }
        int dev = 0, cus = 0, per_cu = 0;
        if (hipGetDevice(&dev) != hipSuccess || hipDeviceGetAttribute(&cus, hipDeviceAttributeMultiprocessorCount, dev) != hipSuccess) { grid = -1; return; }
        if (hipFuncSetAttribute((const void*)fwd, hipFuncAttributeMaxDynamicSharedMemorySize, LDS_BYTES) != hipSuccess) { fprintf(stderr, "kernel_launch: hipFuncSetAttribute failed\n"); grid = -1; return; }
        if (hipOccupancyMaxActiveBlocksPerMultiprocessor(&per_cu, (const void*)fwd, NTHR, LDS_BYTES) != hipSuccess || per_cu < 1) { fprintf(stderr, "kernel_launch: occupancy query reports %d blocks per CU\n", per_cu); }
        (void)hipGetLastError();
        grid = cus;
    }
    if (grid < 0) return;
    (void)hipMemsetAsync((char*)d_ws + WS_CTL, 0, CTL_ZERO_BYTES, stream);
    Args a{};
    for (int i = 0; i < 22; ++i) a.in[i] = (const float*)d_in[i];
    a.out = (float*)d_out; a.ws = (unsigned char*)d_ws;
    hipLaunchKernelGGL(fwd, dim3(grid), dim3(NTHR), LDS_BYTES, stream, a);
}
```

```cpp
#include <hip/hip_runtime.h>
#include <cstdio>
#include <cstdint>
namespace pg8 {
#define PG8_LAS __attribute__((address_space(3)))
typedef unsigned short bf16_t;
typedef short bf16x8 __attribute__((ext_vector_type(8)));
typedef float f32x4 __attribute__((ext_vector_type(4)));
typedef unsigned u32x4 __attribute__((ext_vector_type(4)));
constexpr int BM = 256, BK = 64, HALF = 128, HTB = HALF * BK * 2  , STAGE_BYTES = 8 * HTB, NXCD = 8, WGM = 4;

__host__ __device__ __forceinline__ int lds_byte(int r, int c) { const int st = (r >> 4) * 2 + (c >> 5), rr = r & 15, cc = c & 31, ob = rr * 64 + cc * 2; return st * 1024 + (ob ^ (((ob >> 9) & 1) << 5)); }
__host__ __device__ __forceinline__ void stage_rc(int b, int& R, int& C) { const int st = b / 1024, sb = b % 1024, swz = sb ^ (((sb >> 9) & 1) << 5); R = (st >> 1) * 16 + swz / 64; C = (st & 1) * 32 + (swz % 64) / 2; }
__host__ __device__ __forceinline__ int perm32(int rho) { const int n = rho >> 4, i = rho & 15; return 8 * (i >> 2) + 4 * n + (i & 3); }

struct Unit { int pm, pn, kt0, nt, par; };
struct Gemm { const bf16_t* A; const bf16_t* Bt; int M, N, K; };

struct StaticOrder {
    int nM, nN, nwg, G, c, wgm;
    __host__ __device__ void init(int M, int N, int G_, int c_, int wgm_ = WGM) { nM = M / BM; nN = N / BM; nwg = nM * nN; G = G_; c = c_; wgm = wgm_; }
    __host__ __device__ bool next(int i, Unit& u) const {
        const long L = (long)i * G + c; if (L >= nwg) return false;
        int wgid = (int)L; { const int q = nwg / NXCD, r = nwg % NXCD, xcd = wgid % NXCD, off = wgid / NXCD; wgid = (xcd < r ? xcd * (q + 1) : r * (q + 1) + (xcd - r) * q) + off; }
        const int nig = wgm * nN, gid = wgid / nig, fm = gid * wgm, gsz = (nM - fm) < wgm ? (nM - fm) : wgm;
        u.pm = fm + ((wgid % nig) % gsz); u.pn = (wgid % nig) / gsz; u.kt0 = 0; u.nt = 0; return true;
    }
    __device__ __forceinline__ void a_ready(const Unit&) const {}
    __device__ __forceinline__ void done(const Unit&) const {}
};
struct SplitOrder {
    StaticOrder base; int nmain, npieces, nN, pm_s, pnt;
    __host__ __device__ void init(int Mmain, int N, int K, int G_, int c_, int pnt_ = 4, int wgm_ = WGM) { base.init(Mmain, N, G_, c_, wgm_); nmain = base.nwg; nN = N / BM; pnt = pnt_; npieces = nN * (K / (pnt_ * BK)); pm_s = Mmain / BM; }
    __host__ __device__ bool next(int i, Unit& u) const {
        const long L = (long)i * base.G + base.c; if (L < nmain) return base.next(i, u);
        const int p = (int)(L - nmain); if (p >= npieces) return false;
        u.pm = pm_s; u.pn = p % nN; u.kt0 = (p / nN) * pnt; u.nt = pnt; return true;
    }
    __device__ __forceinline__ void a_ready(const Unit&) const {}
    __device__ __forceinline__ void done(const Unit&) const {}
};


__device__ __forceinline__ unsigned cvt_pk_bf16(float lo, float hi) { unsigned r; asm volatile("v_cvt_pk_bf16_f32 %0, %1, %2" : "=v"(r) : "v"(lo), "v"(hi)); return r; }
typedef float f32x2 __attribute__((ext_vector_type(2)));
__device__ __forceinline__ f32x2 gelu_pk(f32x2 v) {
    const f32x2 av = __builtin_elementwise_abs(v), d = av * 0.2316418882f + 1.0f;
    f32x2 t; t.x = __builtin_amdgcn_rcpf(d.x); t.y = __builtin_amdgcn_rcpf(d.y);
    f32x2 q = t * 0.5307027145f + (-0.7265760135f); q = q * t + 0.7107068705f; q = q * t + (-0.142248368f); q = q * t + 0.127414796f; q = q * t;
    const f32x2 s = (v * v) * (-0.72134752044f);
    f32x2 e; e.x = __builtin_amdgcn_exp2f(s.x); e.y = __builtin_amdgcn_exp2f(s.y);
    const f32x2 m = v * (q * e), r = v - m;
    f32x2 o; o.x = v.x < 0.f ? m.x : r.x; o.y = v.y < 0.f ? m.y : r.y; return o;
}

template <int ACT  > struct EpiBf16 {
    static constexpr bool PERM = true, AFTER_DRAIN = false; static_assert(ACT == 0 || ACT == 1, "EpiBf16: ACT is 0 (none) or 1 (gelu_pk)");
    bf16_t* O; int ldc; const float* bias; int split_cols; size_t split_stride; float scale0;
    __device__ __forceinline__ void operator()(const f32x4 (&acc)[2][2][4][2], const Unit& u, int wr, int wc, int fr, int fq) const {
        const int row0 = u.pm * BM + wr * 64 + fr; int colt = u.pn * BM; bf16_t* base = O;
        float sc = 1.f; if (split_cols) { const int t = colt / split_cols; base += (size_t)t * split_stride; colt -= t * split_cols; if (t == 0) sc = scale0; }
        const int col0 = colt + wc * 32 + 8 * fq, bcol0 = u.pn * BM + wc * 32 + 8 * fq;
        f32x4 bv[2][2];
#pragma unroll
        for (int bj = 0; bj < 2; ++bj)
#pragma unroll
            for (int n = 0; n < 2; ++n) bv[bj][n] = bias ? *(const f32x4*)(bias + bcol0 + bj * HALF + 4 * n) : (f32x4){0.f, 0.f, 0.f, 0.f};
#pragma unroll
        for (int ai = 0; ai < 2; ++ai)
#pragma unroll
            for (int m = 0; m < 4; ++m) { bf16_t* rowp = base + (size_t)(row0 + ai * HALF + m * 16) * ldc + col0;
#pragma unroll
                for (int bj = 0; bj < 2; ++bj) { f32x4 v0 = acc[ai][bj][m][0] + bv[bj][0], v1 = acc[ai][bj][m][1] + bv[bj][1];
                    if (ACT == 1) { f32x2 a = gelu_pk((f32x2){v0[0], v0[1]}), b = gelu_pk((f32x2){v0[2], v0[3]}), c = gelu_pk((f32x2){v1[0], v1[1]}), d = gelu_pk((f32x2){v1[2], v1[3]});
                        v0 = (f32x4){a.x, a.y, b.x, b.y}; v1 = (f32x4){c.x, c.y, d.x, d.y}; }
                    v0 = v0 * sc; v1 = v1 * sc; u32x4 w; w.x = cvt_pk_bf16(v0[0], v0[1]); w.y = cvt_pk_bf16(v0[2], v0[3]); w.z = cvt_pk_bf16(v1[0], v1[1]); w.w = cvt_pk_bf16(v1[2], v1[3]);
                    *(u32x4*)(rowp + bj * HALF) = w; } }
    }
};

typedef unsigned u32x2 __attribute__((ext_vector_type(2)));

template <int M> __device__ __forceinline__ float shx_(float v) { return __int_as_float(__builtin_amdgcn_ds_swizzle(__float_as_int(v), 0x1f | (M << 10))); }
__device__ __forceinline__ float sum_x32_(float v) { auto rr = __builtin_amdgcn_permlane32_swap(__float_as_uint(v), __float_as_uint(v), false, false); return __uint_as_float(rr[0]) + __uint_as_float(rr[1]); }
struct EpiBf16RS {
    static constexpr bool PERM = true, AFTER_DRAIN = false; static constexpr int SMIN = 16;
    bf16_t* O; int ldc; const float* SS; float inv_k, eps; float* vout_p; float* vout_s; int pn_v, mp, mr;
    static constexpr int XL_SS = 140288;
    __device__ __forceinline__ void stage(const Unit& u, PG8_LAS unsigned char* lds, int wid, int lane) const {
        if (wid == 0) __builtin_amdgcn_global_load_lds((const unsigned*)(SS + (size_t)u.pm * BM + lane * 4), (PG8_LAS unsigned*)(lds + XL_SS + u.par * 1024), 16, 0, 0);
    }
    __device__ __forceinline__ void operator()(const f32x4 (&acc)[2][2][4][2], const Unit& u, int wr, int wc, int fr, int fq, PG8_LAS unsigned char* lds) const {
        const int row0 = u.pm * BM + wr * 64 + fr, col0 = u.pn * BM + wc * 32 + 8 * fq; const bool vt = u.pn >= pn_v && u.pn < pn_v + 4; const int vc0 = (u.pn - pn_v) * BM + wc * 32 + 8 * fq;
#pragma unroll
        for (int ai = 0; ai < 2; ++ai)
#pragma unroll
            for (int m = 0; m < 4; ++m) { const int row = row0 + ai * HALF + m * 16; const float rs = rsqrtf(*(const PG8_LAS float*)(lds + XL_SS + u.par * 1024 + (ai * HALF + wr * 64 + m * 16 + fr) * 4) * inv_k + eps); bf16_t* rowp = O + (size_t)row * ldc + col0;
#pragma unroll
                for (int bj = 0; bj < 2; ++bj) { const f32x4 v0 = acc[ai][bj][m][0] * rs, v1 = acc[ai][bj][m][1] * rs;
                    u32x4 w; w.x = cvt_pk_bf16(v0[0], v0[1]); w.y = cvt_pk_bf16(v0[2], v0[3]); w.z = cvt_pk_bf16(v1[0], v1[1]); w.w = cvt_pk_bf16(v1[2], v1[3]);
                    *(u32x4*)(rowp + bj * HALF) = w;
                    if (vt && row < mr) { float* vp = (row < mp ? vout_p + (size_t)row * 1024 : vout_s + (size_t)(row - mp) * 1024) + vc0 + bj * HALF; __builtin_nontemporal_store(v0, (f32x4*)vp); __builtin_nontemporal_store(v1, (f32x4*)(vp + 4)); } } }
    }
};
struct EpiResF32 {
    static constexpr bool PERM = false, AFTER_DRAIN = false; static constexpr int SMIN = 16;
    float* Y; int ldc; int mreal; float* PART; bf16_t* XB; float* SS;
    __device__ __forceinline__ void stage(const Unit&, PG8_LAS unsigned char*, int, int) const {}
    __device__ __forceinline__ void operator()(const f32x4 (&acc)[2][2][4][2], const Unit& u, int wr, int wc, int fr, int fq, PG8_LAS unsigned char*) const {
        const int col0 = u.pn * BM + wc * 32 + 4 * fq;
        if (u.nt) {
            float* P = PART + (size_t)(u.kt0 >> 2) * 128 * ldc;
#pragma unroll
            for (int m = 0; m < 4; ++m) { float* rowp = P + (size_t)(wr * 64 + m * 16 + fr) * ldc + col0;
#pragma unroll
                for (int bj = 0; bj < 2; ++bj)
#pragma unroll
                    for (int n = 0; n < 2; ++n) *(f32x4*)(rowp + bj * HALF + n * 16) = acc[0][bj][m][n]; }
            return;
        }
        const int row0 = u.pm * BM + wr * 64 + fr;
        u32x2 cur[4], nxt[4];
        { const bf16_t* rp = XB + (size_t)row0 * ldc + col0;
#pragma unroll
          for (int q = 0; q < 4; ++q) cur[q] = *(const u32x2*)(rp + (q >> 1) * HALF + (q & 1) * 16); }
#pragma unroll
        for (int g = 0; g < 8; ++g) { const int ai = g >> 2, m = g & 3; const int row = row0 + ai * HALF + m * 16;
            if (g < 7) { const int r2 = row0 + ((g + 1) >> 2) * HALF + ((g + 1) & 3) * 16; const bf16_t* rp = XB + (size_t)r2 * ldc + col0;
#pragma unroll
                for (int q = 0; q < 4; ++q) nxt[q] = *(const u32x2*)(rp + (q >> 1) * HALF + (q & 1) * 16); }
            bf16_t* xbp = XB + (size_t)row * ldc + col0; float ss = 0.f;
#pragma unroll
            for (int q = 0; q < 4; ++q) { const int bj = q >> 1, n = q & 1;
                const f32x4 x = {__uint_as_float(cur[q].x << 16), __uint_as_float(cur[q].x & 0xffff0000u), __uint_as_float(cur[q].y << 16), __uint_as_float(cur[q].y & 0xffff0000u)};
                const f32x4 v = x + acc[ai][bj][m][n];
                if (Y) __builtin_nontemporal_store(v, (f32x4*)(Y + (size_t)row * ldc + col0 + bj * HALF + n * 16));
                else { u32x2 w; w.x = cvt_pk_bf16(v[0], v[1]); w.y = cvt_pk_bf16(v[2], v[3]); *(u32x2*)(xbp + bj * HALF + n * 16) = w; }
                ss += (v[0] * v[0] + v[1] * v[1]) + (v[2] * v[2] + v[3] * v[3]); }
            ss += shx_<16>(ss); ss = sum_x32_(ss);
            if (fq == 0) SS[(size_t)row * 32 + u.pn * 4 + wc] = ss;
#pragma unroll
            for (int q = 0; q < 4; ++q) cur[q] = nxt[q];
        }
    }
};

template <int CTRL> __device__ __forceinline__ float dppf(float old, float src) { return __int_as_float(__builtin_amdgcn_update_dpp(__float_as_int(old), __float_as_int(src), CTRL, 0xf, 0xf, false)); }
struct EpiConv {
    static constexpr bool PERM = true, AFTER_DRAIN = false; static constexpr int SMIN = 16;
    bf16_t* HID; const float* cw; const float* cb; float* GH; float* SBR; float* out_cp; float* out_cs; const float* st_in; int ff, mp, mr, seq; const float* SS; float inv_k, eps; float* PGU; int pnt;
    static constexpr int XL_SS = 140288, XL_CW = 142336;
    __device__ __forceinline__ void stage(const Unit& u, PG8_LAS unsigned char* lds, int wid, int lane) const {
        if (wid == 0 && u.nt == 0) {
            __builtin_amdgcn_global_load_lds((const unsigned*)(SS + (size_t)u.pm * BM + lane * 4), (PG8_LAS unsigned*)(lds + XL_SS + u.par * 1024), 16, 0, 0);
            const int f = u.pn * 128 + (lane & 31) * 4, hs = lane >> 5;
            __builtin_amdgcn_global_load_lds((const unsigned*)(cw + (size_t)hs * ff + f), (PG8_LAS unsigned*)(lds + XL_CW + u.par * 2048), 16, 0, 0);
            __builtin_amdgcn_global_load_lds((const unsigned*)((hs ? cb : cw + 2 * (size_t)ff) + f), (PG8_LAS unsigned*)(lds + XL_CW + u.par * 2048 + 1024), 16, 0, 0);
        }
    }
    __device__ __forceinline__ void operator()(const f32x4 (&acc)[2][2][4][2], const Unit& u, int wr, int wc, int fr, int fq, PG8_LAS unsigned char* lds) const {
        if (u.nt) {
            float* P = PGU + (size_t)(u.kt0 / pnt) * 128 * (2 * ff) + u.pn * BM + wc * 32 + 8 * fq;
#pragma unroll
            for (int m = 0; m < 4; ++m) { float* rowp = P + (size_t)(wr * 64 + m * 16 + fr) * (2 * ff);
#pragma unroll
                for (int bj = 0; bj < 2; ++bj) { *(f32x4*)(rowp + bj * HALF) = acc[0][bj][m][0]; *(f32x4*)(rowp + bj * HALF + 4) = acc[0][bj][m][1]; } }
            return;
        }
        const int f0 = u.pn * 128 + wc * 32 + 8 * fq;
        float w0[8], w1[8], w2[8], bb[8];
        { const PG8_LAS f32x4* p = (const PG8_LAS f32x4*)(lds + XL_CW + u.par * 2048 + (wc * 32 + 8 * fq) * 4);
          const f32x4 a0 = p[0], a1 = p[1], b0 = p[32], b1 = p[33], c0 = p[64], c1 = p[65], d0 = p[96], d1 = p[97];
          w0[0] = a0.x; w0[1] = a0.y; w0[2] = a0.z; w0[3] = a0.w; w0[4] = a1.x; w0[5] = a1.y; w0[6] = a1.z; w0[7] = a1.w;
          w1[0] = b0.x; w1[1] = b0.y; w1[2] = b0.z; w1[3] = b0.w; w1[4] = b1.x; w1[5] = b1.y; w1[6] = b1.z; w1[7] = b1.w;
          w2[0] = c0.x; w2[1] = c0.y; w2[2] = c0.z; w2[3] = c0.w; w2[4] = c1.x; w2[5] = c1.y; w2[6] = c1.z; w2[7] = c1.w;
          bb[0] = d0.x; bb[1] = d0.y; bb[2] = d0.z; bb[3] = d0.w; bb[4] = d1.x; bb[5] = d1.y; bb[6] = d1.z; bb[7] = d1.w; }
#pragma unroll
        for (int ai = 0; ai < 2; ++ai) {
            const int rb = u.pm * BM + ai * HALF + wr * 64, blk = rb >> 6;
            float gp[8];
#pragma unroll
            for (int i = 0; i < 8; ++i) gp[i] = 0.f;
#pragma unroll
            for (int m = 0; m < 4; ++m) {
                const int row = rb + 16 * m + fr; const float rs = rsqrtf(*(const PG8_LAS float*)(lds + XL_SS + u.par * 1024 + (ai * HALF + wr * 64 + 16 * m + fr) * 4) * inv_k + eps);
                float g2[8], g1[8], g0[8], uu[8];
#pragma unroll
                for (int n = 0; n < 2; ++n)
#pragma unroll
                    for (int j = 0; j < 4; ++j) { const int i = 4 * n + j; g2[i] = acc[ai][0][m][n][j] * rs; uu[i] = acc[ai][1][m][n][j] * rs;
                        float o1 = 0.f, o2 = 0.f;
                        if (m > 0) { o1 = dppf<0x121>(0.f, gp[i]); o2 = dppf<0x122>(0.f, gp[i]); }
                        g1[i] = dppf<0x111>(o1, g2[i]); g0[i] = dppf<0x112>(o2, g2[i]); }
#pragma unroll
                for (int i = 0; i < 8; ++i) gp[i] = g2[i];
                if (row >= mp && fr < 2) {
                    int sb = (row - mp) >> 4; if (sb > 7) sb = 7; const float* st = st_in + (size_t)sb * 2 * ff + f0;
                    const f32x4 s1a = *(const f32x4*)(st + ff), s1b = *(const f32x4*)(st + ff + 4); const float s1[8] = {s1a.x, s1a.y, s1a.z, s1a.w, s1b.x, s1b.y, s1b.z, s1b.w};
                    if (fr == 0) { const f32x4 s0a = *(const f32x4*)(st), s0b = *(const f32x4*)(st + 4); const float s0[8] = {s0a.x, s0a.y, s0a.z, s0a.w, s0b.x, s0b.y, s0b.z, s0b.w};
#pragma unroll
                        for (int i = 0; i < 8; ++i) { g1[i] = s1[i]; g0[i] = s0[i]; } }
                    else {
#pragma unroll
                        for (int i = 0; i < 8; ++i) g0[i] = s1[i]; }
                }
                const bool bnd = (m == 0) && (fr < 2) && (row < mp);
                if (bnd) { float* sp = SBR + ((size_t)(blk * 2 + fr) * 2) * ff + f0;
                    *(f32x4*)(sp) = (f32x4){g2[0], g2[1], g2[2], g2[3]}; *(f32x4*)(sp + 4) = (f32x4){g2[4], g2[5], g2[6], g2[7]};
                    *(f32x4*)(sp + ff) = (f32x4){uu[0], uu[1], uu[2], uu[3]}; *(f32x4*)(sp + ff + 4) = (f32x4){uu[4], uu[5], uu[6], uu[7]}; }
                else { float hv[8];
#pragma unroll
                    for (int i = 0; i < 8; ++i) { const float g = bb[i] + w0[i] * g0[i] + w1[i] * g1[i] + w2[i] * g2[i]; hv[i] = g * __builtin_amdgcn_rcpf(1.f + __expf(-g)) * uu[i]; }
                    u32x4 w; w.x = cvt_pk_bf16(hv[0], hv[1]); w.y = cvt_pk_bf16(hv[2], hv[3]); w.z = cvt_pk_bf16(hv[4], hv[5]); w.w = cvt_pk_bf16(hv[6], hv[7]);
                    *(u32x4*)(HID + (size_t)row * ff + f0) = w; }
                if (m == 3 && fr >= 14) { float* gp = GH + ((size_t)blk * 2 + (fr - 14)) * ff + f0;
                    *(f32x4*)(gp) = (f32x4){g2[0], g2[1], g2[2], g2[3]}; *(f32x4*)(gp + 4) = (f32x4){g2[4], g2[5], g2[6], g2[7]};
                    if (row < mp && (row & (seq - 1)) >= seq - 2) { float* cp = out_cp + ((size_t)(row / seq) * 2 + (fr - 14)) * ff + f0;
                        *(f32x4*)(cp) = (f32x4){g2[0], g2[1], g2[2], g2[3]}; *(f32x4*)(cp + 4) = (f32x4){g2[4], g2[5], g2[6], g2[7]}; } }
                if (row >= mp && row < mr && fr >= 14) { float* cp = out_cs + ((size_t)((row - mp) >> 4) * 2 + (fr - 14)) * ff + f0;
                    *(f32x4*)(cp) = (f32x4){g2[0], g2[1], g2[2], g2[3]}; *(f32x4*)(cp + 4) = (f32x4){g2[4], g2[5], g2[6], g2[7]}; }
            }
        }
    }
};
#ifdef PROBE_SEL
#define PG8_PROBE_T() do { if (blockIdx.x == PROBE_BLK && wid == 0) { volatile PG8_LAS unsigned* LC_ = (volatile PG8_LAS unsigned*)(lds + 139264); LC_[13] = (unsigned)__builtin_amdgcn_s_memrealtime(); } } while (0)
#define PG8_PROBE_A(k) do { if (blockIdx.x == PROBE_BLK && wid == 0) { volatile PG8_LAS unsigned* LC_ = (volatile PG8_LAS unsigned*)(lds + 139264); const unsigned n_ = (unsigned)__builtin_amdgcn_s_memrealtime(); if (lane == 0) LC_[32 + 2 * LC_[14] + (k)] += n_ - LC_[13]; LC_[13] = n_; } } while (0)
#else
#define PG8_PROBE_T() do {} while (0)
#define PG8_PROBE_A(k) do {} while (0)
#endif
template <class Epi, class Sched, bool ALIGN_EPI = false, bool SP2 = false>
__device__ __forceinline__ void gemm_phase(PG8_LAS unsigned char* lds, const Gemm g, const Sched& S, const Epi& E) {
    int tid_l = threadIdx.x; asm volatile("" : "+v"(tid_l)); const int tid = tid_l, wid = __builtin_amdgcn_readfirstlane(tid >> 6), lane = tid & 63, wr = wid >> 2, wc = wid & 3, fr = lane & 15, fq = lane >> 4;
    const int K = g.K, nt = K / BK;
    unsigned voffA[2], voffB[2];
#pragma unroll
    for (int i = 0; i < 2; ++i) { int R, C; stage_rc(tid * 16 + i * 8192, R, C); const int Rb = Epi::PERM ? ((R & ~31) + perm32(R & 31)) : R;
        voffA[i] = (unsigned)(R * K + C) * 2u; voffB[i] = (unsigned)(Rb * K + C) * 2u; }
    const size_t kstep = (size_t)(BK * 2);
    const size_t hstep = (size_t)HALF * K * 2;
    const size_t tstep = 2 * hstep;
    const unsigned ldsw = (unsigned)wid * 1024u;
    const int aoff = lds_byte(wr * 64 + fr, fq * 8), boff = lds_byte(wc * 32 + fr, fq * 8);
#define PG8_SA(b, h) (((b) * 2 + (h)) * HTB)
#define PG8_SB(b, h) ((4 + (b) * 2 + (h)) * HTB)
#define PG8_STAGE(bufoff, gbase, voff) do { _Pragma("unroll") for (int _i = 0; _i < 2; ++_i) \
        __builtin_amdgcn_global_load_lds((const unsigned*)((const char*)(gbase) + (voff)[_i]), (PG8_LAS unsigned*)(lds + (bufoff) + ldsw + _i * 8192), 16, 0, 0); } while (0)
#define PG8_LDA(dst, b, h) do { _Pragma("unroll") for (int m = 0; m < 4; ++m) _Pragma("unroll") for (int k = 0; k < 2; ++k) dst[m][k] = *(const PG8_LAS bf16x8*)(lds + PG8_SA(b, h) + aoff + m * 2048 + k * 1024); } while (0)
#define PG8_LDB(dst, b, h) do { _Pragma("unroll") for (int n = 0; n < 2; ++n) _Pragma("unroll") for (int k = 0; k < 2; ++k) dst[n][k] = *(const PG8_LAS bf16x8*)(lds + PG8_SB(b, h) + boff + n * 2048 + k * 1024); } while (0)
#define PG8_MMA(ai, bj, At, Bt) do { __builtin_amdgcn_s_setprio(1); _Pragma("unroll") for (int m = 0; m < 4; ++m) _Pragma("unroll") for (int n = 0; n < 2; ++n) _Pragma("unroll") for (int k = 0; k < 2; ++k) \
        acc[ai][bj][m][n] = __builtin_amdgcn_mfma_f32_16x16x32_bf16(Bt[n][k], At[m][k], acc[ai][bj][m][n], 0, 0, 0); __builtin_amdgcn_s_setprio(0); } while (0)
#define PG8_WAIT_V(n) asm volatile("s_waitcnt vmcnt(" #n ")" ::: "memory")
#define PG8_XSPARE 147456
#define PG8_LDA_OFF(dst, off) do { _Pragma("unroll") for (int m = 0; m < 4; ++m) _Pragma("unroll") for (int k = 0; k < 2; ++k) dst[m][k] = *(const PG8_LAS bf16x8*)(lds + (off) + m * 2048 + k * 1024); } while (0)
#define PG8_WAIT_VS() asm volatile("s_waitcnt vmcnt(%0)" :: "i"(8 + Epi::SMIN) : "memory")
#define PG8_WAIT_L(n) asm volatile("s_waitcnt lgkmcnt(" #n ")" ::: "memory")
#define PG8_BAR __builtin_amdgcn_s_barrier()
#define PG8_SCHED __builtin_amdgcn_sched_barrier(0)
    Unit cur, nxt; int ui = 0;
    if (!S.next(0, cur)) return;
    f32x4 acc[2][2][4][2];
#pragma unroll
    for (int a = 0; a < 2; ++a)
#pragma unroll
        for (int b = 0; b < 2; ++b)
#pragma unroll
            for (int m = 0; m < 4; ++m)
#pragma unroll
                for (int n = 0; n < 2; ++n) acc[a][b][m][n] = (f32x4){0.f, 0.f, 0.f, 0.f};
    bf16x8 At[4][2], B0[2][2], B1[2][2];
    const char* cA = (const char*)g.A + (size_t)cur.pm * tstep + (size_t)cur.kt0 * kstep; const char* cB = (const char*)g.Bt + (size_t)cur.pn * tstep + (size_t)cur.kt0 * kstep;
    S.a_ready(cur);
    cur.par = 0; E.stage(cur, lds, wid, lane);
    if constexpr (SP2) {
        PG8_STAGE(PG8_SB(0, 0), cB, voffB); PG8_STAGE(PG8_SB(0, 1), cB + hstep, voffB); PG8_STAGE(PG8_SA(0, 0), cA, voffA); PG8_STAGE(PG8_SA(0, 1), cA + hstep, voffA);
        if (wr == 1) PG8_BAR;
        PG8_WAIT_V(2); PG8_BAR;
        PG8_STAGE(PG8_SB(1, 0), cB + kstep, voffB); PG8_STAGE(PG8_SA(1, 0), cA + kstep, voffA); PG8_STAGE(PG8_SB(1, 1), cB + hstep + kstep, voffB);
        PG8_WAIT_V(6); PG8_BAR;
    } else {
        PG8_STAGE(PG8_SB(0, 0), cB, voffB); PG8_STAGE(PG8_SA(0, 0), cA, voffA); PG8_STAGE(PG8_SB(0, 1), cB + hstep, voffB); PG8_STAGE(PG8_SA(0, 1), cA + hstep, voffA);
        if (wr == 1) PG8_BAR;
        PG8_WAIT_V(4); PG8_BAR;
        PG8_STAGE(PG8_SB(1, 0), cB + kstep, voffB); PG8_STAGE(PG8_SA(1, 0), cA + kstep, voffA); PG8_STAGE(PG8_SB(1, 1), cB + hstep + kstep, voffB);
        PG8_WAIT_V(6); PG8_BAR;
    }
    for (;;) {
        const bool has_next = S.next(ui + 1, nxt);
        const char* nA = has_next ? (const char*)g.A + (size_t)nxt.pm * tstep + (size_t)nxt.kt0 * kstep : cA; const char* nB = has_next ? (const char*)g.Bt + (size_t)nxt.pn * tstep + (size_t)nxt.kt0 * kstep : cB;
        const int cnt = cur.nt ? cur.nt : nt;
        PG8_PROBE_T();
        int seamf = __builtin_amdgcn_readfirstlane((SP2 && ui > 0) ? 1 : 0); asm volatile("" : "+s"(seamf));
        for (int t = 0; t < cnt; t += 2) {
            const bool last = (t == cnt - 2);
            const char* a1 = cA + (size_t)(t + 1) * kstep;
            const char* a2 = last ? nA : cA + (size_t)(t + 2) * kstep; const char* b2 = last ? nB : cB + (size_t)(t + 2) * kstep;
            const char* a3 = a2 + kstep; const char* b3 = b2 + kstep;
            if (last && has_next) S.a_ready(nxt);
            if constexpr (SP2) {
            const bool seam = seamf != 0; seamf = 0; asm volatile("" : "+s"(seamf));
            PG8_LDB(B0, 0, 0); PG8_LDB(B1, 0, 1); PG8_SCHED; PG8_LDA(At, 0, 0);
            if (seam) { PG8_WAIT_VS(); } else { PG8_STAGE(PG8_SA(1, 1), a1 + hstep, voffA); PG8_WAIT_V(8); }
            PG8_WAIT_L(0); PG8_BAR; PG8_MMA(0, 0, At, B0); PG8_MMA(0, 1, At, B1); PG8_BAR; PG8_SCHED;
            PG8_LDA(At, 0, 1); PG8_STAGE(PG8_SB(0, 0), b2, voffB); PG8_STAGE(PG8_SB(0, 1), b2 + hstep, voffB); PG8_STAGE(PG8_SA(0, 0), a2, voffA);
            if (seam) PG8_WAIT_VS(); else PG8_WAIT_V(8);
            PG8_WAIT_L(0); PG8_BAR; PG8_MMA(1, 0, At, B0); PG8_MMA(1, 1, At, B1); PG8_BAR; PG8_SCHED;
            PG8_LDB(B0, 1, 0); PG8_LDB(B1, 1, 1); PG8_SCHED; PG8_LDA(At, 1, 0); PG8_STAGE(PG8_SA(0, 1), a2 + hstep, voffA);
            if (seam) PG8_WAIT_VS(); else PG8_WAIT_V(8);
            PG8_WAIT_L(0); PG8_BAR; PG8_MMA(0, 0, At, B0); PG8_MMA(0, 1, At, B1); PG8_BAR; PG8_SCHED;
            { const int a11 = aoff + (seam ? PG8_XSPARE : PG8_SA(1, 1)); PG8_LDA_OFF(At, a11); }
            PG8_STAGE(PG8_SB(1, 0), b3, voffB); PG8_STAGE(PG8_SB(1, 1), b3 + hstep, voffB); PG8_STAGE(PG8_SA(1, 0), a3, voffA);
            if (last && has_next) { PG8_STAGE(PG8_XSPARE, a3 + hstep, voffA); PG8_WAIT_V(10); } else PG8_WAIT_V(8);
            PG8_WAIT_L(0); PG8_BAR; PG8_MMA(1, 0, At, B0); PG8_MMA(1, 1, At, B1); PG8_BAR; PG8_SCHED;
            } else {
            PG8_LDB(B0, 0, 0); PG8_SCHED; PG8_LDA(At, 0, 0); PG8_STAGE(PG8_SA(1, 1), a1 + hstep, voffA);
            PG8_WAIT_L(8); PG8_BAR; PG8_WAIT_L(0); PG8_MMA(0, 0, At, B0); PG8_BAR; PG8_SCHED;
            PG8_LDB(B1, 0, 1); PG8_STAGE(PG8_SB(0, 0), b2, voffB);
            PG8_BAR; PG8_WAIT_L(0); PG8_MMA(0, 1, At, B1); PG8_BAR;
            PG8_LDA(At, 0, 1); PG8_STAGE(PG8_SA(0, 0), a2, voffA);
            PG8_BAR; PG8_WAIT_L(0); PG8_MMA(1, 0, At, B0); PG8_BAR; PG8_SCHED;
            PG8_STAGE(PG8_SB(0, 1), b2 + hstep, voffB);
            PG8_WAIT_V(6); PG8_BAR; PG8_MMA(1, 1, At, B1); PG8_BAR;
            PG8_LDB(B0, 1, 0); PG8_SCHED; PG8_LDA(At, 1, 0); PG8_STAGE(PG8_SA(0, 1), a2 + hstep, voffA);
            PG8_WAIT_L(8); PG8_BAR; PG8_WAIT_L(0); PG8_MMA(0, 0, At, B0); PG8_BAR; PG8_SCHED;
            PG8_LDB(B1, 1, 1); PG8_STAGE(PG8_SB(1, 0), b3, voffB);
            PG8_BAR; PG8_WAIT_L(0); PG8_MMA(0, 1, At, B1); PG8_BAR;
            PG8_LDA(At, 1, 1); PG8_STAGE(PG8_SA(1, 0), a3, voffA);
            PG8_BAR; PG8_WAIT_L(0); PG8_MMA(1, 0, At, B0); PG8_BAR; PG8_SCHED;
            PG8_STAGE(PG8_SB(1, 1), b3 + hstep, voffB);
            PG8_WAIT_V(6); PG8_BAR; PG8_MMA(1, 1, At, B1); PG8_BAR;
            }
        }
        PG8_PROBE_A(0);
        if constexpr (ALIGN_EPI) { if (wr == 0) PG8_BAR; }
        if constexpr (!Epi::AFTER_DRAIN) { E(acc, cur, wr, wc, fr, fq, lds); S.done(cur); }
        PG8_PROBE_A(1);
        if (!has_next) break;
#pragma unroll
        for (int a = 0; a < 2; ++a)
#pragma unroll
            for (int b = 0; b < 2; ++b)
#pragma unroll
                for (int m = 0; m < 4; ++m)
#pragma unroll
                    for (int n = 0; n < 2; ++n) acc[a][b][m][n] = (f32x4){0.f, 0.f, 0.f, 0.f};
        cur = nxt; cA = nA; cB = nB; ++ui; cur.par = ui & 1; E.stage(cur, lds, wid, lane);
        if constexpr (ALIGN_EPI) { if (wr == 1) PG8_BAR; }
    }
    PG8_WAIT_V(0);
    if constexpr (!ALIGN_EPI) { if (wr == 0) PG8_BAR; }
    PG8_BAR;
    if constexpr (Epi::AFTER_DRAIN) { E.fused(acc, cur, wr, wc, fr, fq, lds, wid, lane); S.done(cur); }
#undef PG8_SA
#undef PG8_SB
#undef PG8_STAGE
#undef PG8_LDA
#undef PG8_LDB
#undef PG8_MMA
#undef PG8_WAIT_V
#undef PG8_WAIT_VS
#undef PG8_LDA_OFF
#undef PG8_WAIT_L
#undef PG8_BAR
#undef PG8_SCHED
}
}
#define GAS __attribute__((address_space(1)))
#define LAS __attribute__((address_space(3)))
typedef unsigned short bf16;
typedef unsigned v4u __attribute__((ext_vector_type(4)));
typedef float f32x4 __attribute__((ext_vector_type(4)));
typedef short bf16x8 __attribute__((ext_vector_type(8)));
typedef GAS unsigned gu32;
typedef GAS unsigned long long gu64;
#define RLX_AGENT __ATOMIC_RELAXED, __HIP_MEMORY_SCOPE_AGENT
#define LDS_WAIT() asm volatile("s_waitcnt lgkmcnt(0)" ::: "memory")
#define VM_WAIT() asm volatile("s_waitcnt vmcnt(0)" ::: "memory")
__device__ __forceinline__ unsigned long long rt() { return __builtin_amdgcn_s_memrealtime(); }
__device__ __forceinline__ unsigned f2bf(float f) { unsigned u = __builtin_bit_cast(unsigned, f); return (u + 0x7fffu + ((u >> 16) & 1u)) >> 16; }
__device__ __forceinline__ unsigned pk2(float lo, float hi) { return f2bf(lo) | (f2bf(hi) << 16); }

#define XB_TMO      128
#define XB_XCNT(j)  (256  + 64 * (j))
#define XB_XSUB(j)  (1280 + 64 * (j))
#define XB_XGEN(j)  (2304 + 64 * (j))
#define XB_TOP      3328
#define XB_TOPGEN   3392
#define XCD_BAR_WORDS 3456
#define XB_SPIN_CAP (1u << 18)

__device__ __forceinline__ unsigned xb_ld(unsigned* p)              { return __hip_atomic_load(p, __ATOMIC_RELAXED, __HIP_MEMORY_SCOPE_AGENT); }
__device__ __forceinline__ unsigned xb_add(unsigned* p, unsigned v) { return __hip_atomic_fetch_add(p, v, __ATOMIC_RELAXED, __HIP_MEMORY_SCOPE_AGENT); }
__device__ __forceinline__ unsigned xb_xcc_id() { return (unsigned)__builtin_amdgcn_s_getreg((3 << 11) | 20) & 0xFu; }
#define XB_SPIN(cond, bar) do { unsigned _sp = 0; while (cond) { __builtin_amdgcn_s_sleep(1); \
    if ((++_sp & 255u) == 0u) { if (xb_ld(&(bar)[XB_TMO])) break; if (_sp > XB_SPIN_CAP) { atomicAdd(&(bar)[XB_TMO], 1u); break; } } } } while (0)

struct XcdBarrier {
    unsigned* bar; unsigned x;
    volatile LAS unsigned* st;
};

__device__ __forceinline__ XcdBarrier xcd_barrier_post(unsigned* bar, volatile LAS unsigned* st) {
    XcdBarrier b; b.bar = bar; b.x = xb_xcc_id(); b.st = st;
    if (threadIdx.x == 0) (void)xb_add(&bar[XB_XCNT(b.x)], 1u);
    return b;
}
__device__ __forceinline__ void xcd_barrier_complete(unsigned* bar, unsigned x, unsigned& nloc, unsigned& nx) {
    const unsigned G = gridDim.x * gridDim.y * gridDim.z;
    unsigned sum, cnt, mine, sp = 0u;
    for (;;) {
        sum = 0u; cnt = 0u; mine = 0u;
#pragma unroll
        for (unsigned j = 0; j < 16; ++j) { const unsigned c = xb_ld(&bar[XB_XCNT(j)]); sum += c; cnt += (c > 0u) ? 1u : 0u; mine = (j == x) ? c : mine; }
        if (sum == G) break;
        __builtin_amdgcn_s_sleep(1);
        if ((++sp & 255u) == 0u) { if (xb_ld(&bar[XB_TMO])) break; if (sp > XB_SPIN_CAP) { atomicAdd(&bar[XB_TMO], 1u); break; } }
    }
    nloc = mine > 0u ? mine : 1u; nx = cnt > 0u ? cnt : 1u;
}

__device__ __forceinline__ void xcd_barrier(const XcdBarrier& b) {
    asm volatile("s_waitcnt vmcnt(0)" ::: "memory");
    __syncthreads();
    if (threadIdx.x == 0) {
        unsigned* bar = b.bar;
        __builtin_amdgcn_s_waitcnt(0);
        unsigned nloc = b.st[0], nx = b.st[1];
        if (nloc == 0u) { xcd_barrier_complete(bar, b.x, nloc, nx); b.st[0] = nloc; b.st[1] = nx; }
        const unsigned old = xb_add(&bar[XB_XSUB(b.x)], 1u);
        const unsigned gen = old / nloc;
        if (old + 1u == (gen + 1u) * nloc) {
            __builtin_amdgcn_fence(__ATOMIC_RELEASE, "agent");
            asm volatile("s_waitcnt vmcnt(0)" ::: "memory");
            const unsigned og = xb_add(&bar[XB_TOP], 1u);
            const unsigned tg = og / nx;
            if (og + 1u == (tg + 1u) * nx) xb_add(&bar[XB_TOPGEN], 1u);
            else XB_SPIN(xb_ld(&bar[XB_TOPGEN]) == tg, bar);
            __builtin_amdgcn_fence(__ATOMIC_ACQUIRE, "agent");
            xb_add(&bar[XB_XGEN(b.x)], 1u);
            asm volatile("s_waitcnt vmcnt(0)" ::: "memory");
        } else {
            XB_SPIN(xb_ld(&bar[XB_XGEN(b.x)]) == gen, bar);
            __builtin_amdgcn_fence(__ATOMIC_ACQUIRE, "agent");
            asm volatile("s_waitcnt vmcnt(0)" ::: "memory");
        }
    }
    __syncthreads();
}

constexpr int DM = 2048, NBATCH = 2, SEQ = 8192, NL = 4, DECB = 8, DECS = 16, PAST = 2048;
constexpr int MP = NBATCH * SEQ;
constexpr int MS = DECB * DECS;
constexpr int MR = MP + MS;
constexpr int MT = 16640;
constexpr int INW = 5648, NIN = 5888, FF = 5632, NGU = 2 * FF;
constexpr int C_CU = 0, C_CV = 512, C_GQ = 1024, C_GK = 1280, C_GV = 1536, C_GR = 2048, C_SQ = 2560, C_SK = 3584, C_SV = 4608, C_LR = 5632;
constexpr float EPS = 1e-6f;
constexpr float QSCALE = 0.08838834764831845f * 1.4426950408889634f;

constexpr size_t O_Y = 0;
constexpr size_t O_KP = (size_t)MR * DM;
constexpr size_t O_VP = O_KP + (size_t)NL * MP * 1024;
constexpr size_t O_GP = O_VP + (size_t)NL * MP * 1024;
constexpr size_t O_CP = O_GP + (size_t)NL * NBATCH * 4 * 64 * 128;
constexpr size_t O_KS = O_CP + (size_t)NL * NBATCH * 2 * FF;
constexpr size_t O_VS = O_KS + (size_t)NL * MS * 1024;
constexpr size_t O_GS = O_VS + (size_t)NL * MS * 1024;
constexpr size_t O_CS = O_GS + (size_t)NL * DECB * 4 * 64 * 128;
constexpr size_t O_CM = O_CS + (size_t)NL * DECB * 2 * FF;
constexpr size_t O_END = O_CM + (size_t)NL * MS * 512;

constexpr size_t MiB = 1u << 20;
constexpr size_t WS_CTL = 0, CTL_ZERO_BYTES = 1 * MiB;
constexpr size_t SZ_WIN = (size_t)NIN * DM * 2, SZ_WOUT = (size_t)DM * DM * 2, SZ_WGU = (size_t)NGU * DM * 2, SZ_WDN = (size_t)DM * FF * 2;
constexpr size_t SZ_WL = SZ_WIN + SZ_WOUT + SZ_WGU + SZ_WDN;
constexpr size_t WS_W = 1 * MiB;
constexpr size_t WS_H = WS_W + NL * SZ_WL;
constexpr size_t WS_HID = WS_H + (size_t)MT * DM * 2;
constexpr size_t WS_RA = WS_HID + (size_t)MT * FF * 2;
constexpr size_t WS_PROJ = WS_RA;
constexpr size_t WS_MIX = WS_PROJ + (size_t)MT * NIN * 2;
constexpr size_t WS_GLAU = WS_MIX + (size_t)MT * DM * 2;
constexpr size_t WS_GLAD = WS_GLAU + (size_t)1024 * 8192 * 4;
constexpr size_t WS_GH = WS_GLAD + (size_t)1024 * 64 * 4;
constexpr size_t WS_SBR = WS_GH + (size_t)260 * 2 * FF * 4;
constexpr size_t WS_PART = WS_SBR + (size_t)256 * 2 * 2 * FF * 4;
constexpr int NP_OUT = DM / 256, NP_DN = FF / 256;
constexpr size_t WS_SS1 = WS_PART + (size_t)NP_DN * 128 * DM * 4;
constexpr size_t WS_SS2 = WS_SS1 + (size_t)MT * 4;
constexpr size_t WS_SSP = WS_SS2 + (size_t)MT * 4;
constexpr int GU_PNT = 8, NP_GU = DM / (GU_PNT * 64);
constexpr size_t WS_PGU = WS_SSP + (size_t)MP * 32 * 4;
constexpr size_t WS_GLAF = WS_PGU + (size_t)NP_GU * 128 * NGU * 4;
constexpr size_t WS_END = WS_GLAF + (size_t)1024 * 36864;
static_assert(WS_W % 256 == 0 && SZ_WL % 256 == 0 && WS_H % 256 == 0 && WS_HID % 256 == 0 && WS_RA % 256 == 0 && WS_MIX % 256 == 0 && WS_GLAU % 256 == 0 && WS_GH % 256 == 0 && WS_SBR % 256 == 0, "alignment");

constexpr int CW_BAR = 4096;
constexpr int CW_Q = 16384;
static_assert((CW_Q + 64 * 64) * 4 <= (int)CTL_ZERO_BYTES, "ctl");

constexpr int SCR_BYTES = 139264;
constexpr int LCTL_OFF = SCR_BYTES;
constexpr int LDS_BYTES = 163840;
static_assert(LCTL_OFF + 256 <= LDS_BYTES, "lds");
constexpr int NWAVES = 8, NTHR = 512;
#ifndef WGM_IN
#define WGM_IN 4
#define WGM_OUT 4
#define WGM_GU 4
#define WGM_DN 4
#endif

struct Args { const float* in[22]; float* out; unsigned char* ws; };
typedef const __attribute__((address_space(4))) Args* KArgs;
__device__ __forceinline__ KArgs kargs() { KArgs p = (KArgs)__builtin_amdgcn_kernarg_segment_ptr(); asm volatile("" : "+s"(p)); return p; }
__device__ __forceinline__ int fresh_tid() { int t = threadIdx.x; asm volatile("" : "+v"(t)); return t; }
__device__ __forceinline__ int fresh_bx() { int t = blockIdx.x; asm volatile("" : "+s"(t)); return t; }


__device__ __forceinline__ float bf_lo(unsigned w) { return __uint_as_float(w << 16); }
__device__ __forceinline__ float bf_hi(unsigned w) { return __uint_as_float(w & 0xffff0000u); }
__device__ __forceinline__ unsigned pkbf(float lo, float hi) { return pg8::cvt_pk_bf16(lo, hi); }
__device__ __forceinline__ float gelu_t(float x) { const float in = x + 0.044715f * x * x * x; return x * __builtin_amdgcn_rcpf(1.f + __expf(-1.5957691216057308f * in)); }
__device__ __forceinline__ float silu_f(float x) { return x * __builtin_amdgcn_rcpf(1.f + __expf(-x)); }
__device__ __forceinline__ float logsig_f(float x) { return fminf(x, 0.f) - __logf(1.f + __expf(-fabsf(x))); }
typedef float f32x2 __attribute__((ext_vector_type(2)));
template <int M> __device__ __forceinline__ float shx(float v) { static_assert(M >= 1 && M < 32, "shx"); return __int_as_float(__builtin_amdgcn_ds_swizzle(__float_as_int(v), 0x1f | (M << 10))); }
__device__ __forceinline__ float sum_x32(float v) { auto rr = __builtin_amdgcn_permlane32_swap(__float_as_uint(v), __float_as_uint(v), false, false); return __uint_as_float(rr[0]) + __uint_as_float(rr[1]); }
__device__ __forceinline__ float bperm(float v, int srclane) { return __int_as_float(__builtin_amdgcn_ds_bpermute(srclane << 2, __float_as_int(v))); }
using pg8::u32x2;

struct CvItem { const float* W; const float* gk; bf16* WT; int ldw, sc, nv, k0, K, dr; };
constexpr int IT_WIN = (DM / 64) * (NIN / 64), IT_WOUT = (DM / 64) * (DM / 64), IT_WG = (DM / 64) * (FF / 64), IT_WD = (FF / 64) * (DM / 64);
constexpr int IT_L = IT_WIN + IT_WOUT + 2 * IT_WG + IT_WD;
__device__ __forceinline__ CvItem cv_decode(KArgs a, unsigned char* ws, int l, int r) {
    unsigned char* wl = ws + WS_W + (size_t)l * SZ_WL;
    CvItem c; c.gk = nullptr; c.nv = 64; c.K = DM;
    if (r < IT_WIN) { const int nblk = NIN / 64, kb = r / nblk, nb = r - kb * nblk, d0 = nb * 64;
        if (d0 < 2560) { c.sc = d0; } else if (d0 < 5632) { c.sc = d0 + 16; } else if (d0 == 5632) { c.sc = 2560; c.nv = 16; } else { c.sc = 0; c.nv = 0; }
        c.W = a->in[7] + (size_t)l * DM * INW; c.ldw = INW; c.k0 = kb * 64; c.WT = (bf16*)wl; c.dr = d0; c.gk = a->in[6] + (size_t)l * DM; }
    else if (r < IT_WIN + IT_WOUT) { r -= IT_WIN; const int nblk = DM / 64, kb = r / nblk, nb = r - kb * nblk;
        c.W = a->in[15] + (size_t)l * DM * DM; c.ldw = DM; c.sc = nb * 64; c.k0 = kb * 64; c.WT = (bf16*)(wl + SZ_WIN); c.dr = nb * 64; }
    else if (r < IT_WIN + IT_WOUT + 2 * IT_WG) { r -= IT_WIN + IT_WOUT; const int up = r >= IT_WG ? 1 : 0; r -= up * IT_WG; const int nblk = FF / 64, kb = r / nblk, nb = r - kb * nblk, f0 = nb * 64;
        c.W = (up ? a->in[18] : a->in[17]) + (size_t)l * DM * FF; c.ldw = FF; c.sc = f0; c.k0 = kb * 64; c.WT = (bf16*)(wl + SZ_WIN + SZ_WOUT); c.dr = (f0 >> 7) * 256 + (f0 & 127) + up * 128; c.gk = a->in[16] + (size_t)l * DM; }
    else { r -= IT_WIN + IT_WOUT + 2 * IT_WG; const int nblk = DM / 64, kb = r / nblk, nb = r - kb * nblk;
        c.W = a->in[21] + (size_t)l * FF * DM; c.ldw = DM; c.sc = nb * 64; c.k0 = kb * 64; c.WT = (bf16*)(wl + SZ_WIN + SZ_WOUT + SZ_WGU); c.K = FF; c.dr = nb * 64; }
    return c;
}
__device__ __forceinline__ void cv_load(const CvItem& c, int lane, f32x4 (&v)[16], f32x4& g0, f32x4& g1) {
    const int c4 = (lane & 15) * 4, kr = lane >> 4;
    g0 = (f32x4){1.f, 1.f, 1.f, 1.f}; g1 = g0; if (c.gk) { g0 = *(const GAS f32x4*)(c.gk + c.k0 + 8 * (lane & 7)); g1 = *(const GAS f32x4*)(c.gk + c.k0 + 8 * (lane & 7) + 4); }
    const float* wp = c.W + (size_t)(c.k0 + kr) * c.ldw + c.sc + (c4 < c.nv ? c4 : 0);
#pragma unroll
    for (int i = 0; i < 16; ++i) v[i] = *(const GAS f32x4*)(wp + (size_t)(4 * i) * c.ldw);
}
__device__ __forceinline__ void cv_to_lds(const CvItem& c, LAS float* scr, int lane, const f32x4 (&v)[16]) {
    const int c4 = (lane & 15) * 4, kr = lane >> 4; const bool ok = c4 < c.nv;
#pragma unroll
    for (int i = 0; i < 16; ++i) { LAS float* d = scr + (4 * i + kr) * 65 + c4; const f32x4 x = ok ? v[i] : (f32x4){0.f, 0.f, 0.f, 0.f}; d[0] = x.x; d[1] = x.y; d[2] = x.z; d[3] = x.w; }
    LDS_WAIT(); asm volatile("" ::: "memory");
}
__device__ __forceinline__ void cv_emit(const CvItem& c, LAS float* scr, int lane, const f32x4 g0, const f32x4 g1) {
    const int cc = lane & 7;
#pragma unroll
    for (int jj = 0; jj < 8; ++jj) { const int n = (lane >> 3) + 8 * jj; const LAS float* s = scr + (8 * cc) * 65 + n;
        v4u o; o.x = pkbf(s[0 * 65] * g0.x, s[1 * 65] * g0.y); o.y = pkbf(s[2 * 65] * g0.z, s[3 * 65] * g0.w); o.z = pkbf(s[4 * 65] * g1.x, s[5 * 65] * g1.y); o.w = pkbf(s[6 * 65] * g1.z, s[7 * 65] * g1.w);
        *(GAS v4u*)(c.WT + (size_t)(c.dr + n) * c.K + c.k0 + 8 * cc) = o; }
    LDS_WAIT(); asm volatile("" ::: "memory");
}
__device__ __forceinline__ void p0_prologue(KArgs a, LAS unsigned char* lds, int gw, int NGW, int wave, int lane, int gtid, int GT) {
    LAS float* scr = (LAS float*)(lds + wave * 16640);
    unsigned char* ws = a->ws;
    if (gw < NL * IT_L) {
        f32x4 v[16], gc0, gc1, gn0, gn1; CvItem cur = cv_decode(a, ws, gw / IT_L, gw % IT_L); cv_load(cur, lane, v, gc0, gc1);
        for (int it = gw; it < NL * IT_L; it += NGW) {
            cv_to_lds(cur, scr, lane, v);
            const int itn = it + NGW; CvItem nxt = cur; gn0 = gc0; gn1 = gc1;
            if (itn < NL * IT_L) { nxt = cv_decode(a, ws, itn / IT_L, itn % IT_L); cv_load(nxt, lane, v, gn0, gn1); }
            cv_emit(cur, scr, lane, gc0, gc1);
            cur = nxt; gc0 = gn0; gc1 = gn1;
        }
    }
    for (int m = gw; m < MR; m += NGW) {
        const float* src = m < MP ? a->in[0] + (size_t)m * DM : a->in[1] + (size_t)(m - MP) * DM;
        const GAS f32x4* s4 = (const GAS f32x4*)src + lane; GAS f32x4* d4 = (GAS f32x4*)(a->out + (size_t)m * DM) + lane; GAS u32x2* b4 = (GAS u32x2*)(ws + WS_H + (size_t)m * DM * 2) + lane;
        float ss = 0.f; f32x4 vv[8];
#pragma unroll
        for (int j = 0; j < 8; ++j) vv[j] = s4[64 * j];
#pragma unroll
        for (int j = 0; j < 8; ++j) { const f32x4 v = vv[j]; if (m >= MP) d4[64 * j] = v; u32x2 w; w.x = pkbf(v.x, v.y); w.y = pkbf(v.z, v.w); b4[64 * j] = w; ss += (v.x * v.x + v.y * v.y) + (v.z * v.z + v.w * v.w); }
        ss += shx<1>(ss); ss += shx<2>(ss); ss += shx<4>(ss); ss += shx<8>(ss); ss += shx<16>(ss); ss = sum_x32(ss);
        if (lane == 0) ((float*)(ws + WS_SS1))[m] = ss;
    }
    for (int i = gtid; i < MT; i += GT) { ((float*)(ws + WS_SS2))[i] = 0.f; if (i >= MR) ((float*)(ws + WS_SS1))[i] = 0.f; }
    { const v4u z = {0u, 0u, 0u, 0u};
      const int nH = (MT - MR) * DM * 2 / 16, nF = (MT - MR) * FF * 2 / 16;
      GAS v4u* pH = (GAS v4u*)(ws + WS_H + (size_t)MR * DM * 2); GAS v4u* pM = (GAS v4u*)(ws + WS_MIX + (size_t)MR * DM * 2); GAS v4u* pF = (GAS v4u*)(ws + WS_HID + (size_t)MR * FF * 2);
      for (int i = gtid; i < nH; i += GT) { pH[i] = z; pM[i] = z; }
      for (int i = gtid; i < nF; i += GT) pF[i] = z; }
}

__device__ __forceinline__ void sample_rows_phase(float* X, bf16* XB, float* SSo, const float* SSP, const float* PART, int np, LAS unsigned char* lds, int bx, int G, int tid) {
    const int wave = tid >> 6, lane = tid & 63;
    for (int rs = bx; rs < MS; rs += G) {
        const int m = MP + rs;
        GAS f32x4* xr = (GAS f32x4*)(X + (size_t)m * DM) + tid;
        f32x4 v = *xr;
        f32x4 acc = {0.f, 0.f, 0.f, 0.f};
#pragma unroll 11
        for (int p = 0; p < np; ++p) acc += *((const GAS f32x4*)(PART + ((size_t)p * 128 + rs) * DM) + tid);
        v += acc;
        if (np > 0) *xr = v;
        float ss = (v.x * v.x + v.y * v.y) + (v.z * v.z + v.w * v.w);
        ss += shx<1>(ss); ss += shx<2>(ss); ss += shx<4>(ss); ss += shx<8>(ss); ss += shx<16>(ss); ss = sum_x32(ss);
        if (XB) { u32x2 w; w.x = pkbf(v.x, v.y); w.y = pkbf(v.z, v.w); *((GAS u32x2*)(XB + (size_t)m * DM) + tid) = w;
            LAS float* red = (LAS float*)lds;
            __syncthreads();
            if (lane == 0) red[wave] = ss;
            __syncthreads();
            if (tid == 0) SSo[m] = ((red[0] + red[1]) + (red[2] + red[3])) + ((red[4] + red[5]) + (red[6] + red[7])); }
    }
    if (SSP) { const int nb = G > MS ? G - MS : G, b0 = G > MS ? bx - MS : bx;
        if (b0 >= 0) for (int r = b0 * NTHR + tid; r < MP; r += nb * NTHR) { const GAS f32x4* p = (const GAS f32x4*)(SSP + (size_t)r * 32); float s = 0.f;
#pragma unroll
            for (int k = 0; k < 8; ++k) { const f32x4 q = p[k]; s += (q.x + q.y) + (q.z + q.w); }
            SSo[r] = s; } }
}

__device__ __forceinline__ void unpack16(const v4u a, const v4u b, float (&x)[16]) {
    x[0] = bf_lo(a.x); x[1] = bf_hi(a.x); x[2] = bf_lo(a.y); x[3] = bf_hi(a.y); x[4] = bf_lo(a.z); x[5] = bf_hi(a.z); x[6] = bf_lo(a.w); x[7] = bf_hi(a.w);
    x[8] = bf_lo(b.x); x[9] = bf_hi(b.x); x[10] = bf_lo(b.y); x[11] = bf_hi(b.y); x[12] = bf_lo(b.z); x[13] = bf_hi(b.z); x[14] = bf_lo(b.w); x[15] = bf_hi(b.w);
}
__device__ __forceinline__ void unpack8(const v4u a, float (&x)[8]) {
    x[0] = bf_lo(a.x); x[1] = bf_hi(a.x); x[2] = bf_lo(a.y); x[3] = bf_hi(a.y); x[4] = bf_lo(a.z); x[5] = bf_hi(a.z); x[6] = bf_lo(a.w); x[7] = bf_hi(a.w);
}
__device__ __forceinline__ v4u pack8f(const float (&x)[8]) { v4u o; o.x = pkbf(x[0], x[1]); o.y = pkbf(x[2], x[3]); o.z = pkbf(x[4], x[5]); o.w = pkbf(x[6], x[7]); return o; }

constexpr int GSEG = 2, NGLA_P = 8 * (128 / GSEG);
constexpr int GB_CUM = 0;
constexpr int GB_GS = 17408;
constexpr int GB_DV = 19456;
constexpr int GB_SSQ = 19712;
constexpr int GB_QE = 20480;
constexpr int GB_KE = 29696;
constexpr int GB_KDT = 38912;
constexpr int GB_ATT = 48128;
constexpr int GB_VT = 57344;
constexpr int GB_ST = 75776;
static_assert(GB_ST + 128 * 72 * 2 <= SCR_BYTES, "gla lds");
typedef LAS unsigned char* lbytes;
__device__ __forceinline__ unsigned short bf1(float x) { return (unsigned short)(pkbf(x, 0.f) & 0xffffu); }
__device__ __forceinline__ bf16x8 ldfrag(lbytes L, int off) { return *(const LAS bf16x8*)(L + off); }

__device__ __forceinline__ void gla_front(lbytes L, const bf16* PROJ, int r0, int nrows, int h, const float* __restrict__ w2l, const float* __restrict__ bl, int tid) {
    LAS float* CUM = (LAS float*)(L + GB_CUM); LAS float* GS = (LAS float*)(L + GB_GS);
    __syncthreads();
    v4u qraw = {0u, 0u, 0u, 0u}, kraw = {0u, 0u, 0u, 0u};
    { const int s = tid >> 3, c = tid & 7; const bool ok = s < nrows; const bf16* prow = PROJ + (size_t)(r0 + s) * NIN;
      if (ok) { qraw = *(const GAS v4u*)(prow + C_GQ + h * 64 + c * 8); kraw = *(const GAS v4u*)(prow + C_GK + h * 64 + c * 8); }
      { float x[16]; if (ok) { const GAS v4u* p = (const GAS v4u*)(prow + C_GV + h * 128 + c * 16); unpack16(p[0], p[1], x); } else {
#pragma unroll
            for (int i = 0; i < 16; ++i) x[i] = 0.f; }
        LAS unsigned short* vt = (LAS unsigned short*)(L + GB_VT) + (c * 16) * 72 + s;
#pragma unroll
        for (int i = 0; i < 16; ++i) vt[i * 72] = bf1(x[i]); }
      { float acc[8];
#pragma unroll
        for (int i = 0; i < 8; ++i) acc[i] = 0.f;
        if (ok) { float g[16]; { const GAS v4u* p = (const GAS v4u*)(prow + C_LR); unpack16(p[0], p[1], g); }
            const int d0 = h * 64 + c * 8;
#pragma unroll
            for (int i = 0; i < 8; ++i) acc[i] = bl[d0 + i];
#pragma unroll
            for (int j = 0; j < 16; ++j) { const GAS f32x4* w = (const GAS f32x4*)(w2l + j * 256 + d0); const f32x4 w0 = w[0], w1 = w[1];
                acc[0] += g[j] * w0.x; acc[1] += g[j] * w0.y; acc[2] += g[j] * w0.z; acc[3] += g[j] * w0.w; acc[4] += g[j] * w1.x; acc[5] += g[j] * w1.y; acc[6] += g[j] * w1.z; acc[7] += g[j] * w1.w; }
#pragma unroll
            for (int i = 0; i < 8; ++i) acc[i] = logsig_f(acc[i]) * (1.f / 16.f); }
        LAS f32x4* d = (LAS f32x4*)(CUM + s * 68 + c * 8); d[0] = (f32x4){acc[0], acc[1], acc[2], acc[3]}; d[1] = (f32x4){acc[4], acc[5], acc[6], acc[7]}; } }
    __syncthreads();
    { const int d = tid & 63, sg = tid >> 6; float x[8]; float run = 0.f;
#pragma unroll
      for (int i = 0; i < 8; ++i) { run += CUM[(sg * 8 + i) * 68 + d]; x[i] = run; }
      GS[sg * 64 + d] = run;
      __syncthreads();
      float off = 0.f;
#pragma unroll
      for (int g = 0; g < 8; ++g) { const float t = GS[g * 64 + d]; off += (g < sg) ? t : 0.f; }
#pragma unroll
      for (int i = 0; i < 8; ++i) CUM[(sg * 8 + i) * 68 + d] = x[i] + off; }
    __syncthreads();
    { const int s = tid >> 3, c = tid & 7, d0 = c * 8;
      float q[8], k[8]; unpack8(qraw, q); unpack8(kraw, k);
      const LAS f32x4* cp = (const LAS f32x4*)(CUM + s * 68 + d0); const LAS f32x4* lp = (const LAS f32x4*)(CUM + 63 * 68 + d0);
      const f32x4 c0 = cp[0], c1 = cp[1], l0 = lp[0], l1 = lp[1];
      const float cum[8] = {c0.x, c0.y, c0.z, c0.w, c1.x, c1.y, c1.z, c1.w}, last[8] = {l0.x, l0.y, l0.z, l0.w, l1.x, l1.y, l1.z, l1.w};
      float qe[8], ke[8];
      LAS unsigned short* kdt = (LAS unsigned short*)(L + GB_KDT) + d0 * 72 + s;
#pragma unroll
      for (int i = 0; i < 8; ++i) { qe[i] = q[i] * __expf(cum[i]) * 0.125f; ke[i] = k[i] * __expf(-cum[i]); kdt[i * 72] = bf1(k[i] * __expf(last[i] - cum[i])); }
      *(LAS v4u*)(L + GB_QE + s * 144 + d0 * 2) = pack8f(qe); *(LAS v4u*)(L + GB_KE + s * 144 + d0 * 2) = pack8f(ke);
      if (s == 0) { LAS float* DV = (LAS float*)(L + GB_DV);
#pragma unroll
          for (int i = 0; i < 8; ++i) DV[d0 + i] = __expf(last[i]); } }
    __syncthreads();
}
__device__ __forceinline__ void gla_U(lbytes L, int wv, int r, int quad, f32x4 (&u)[4]) {
    const int td = wv >> 1, te0 = (wv & 1) * 4;
    const bf16x8 a0 = ldfrag(L, GB_KDT + (16 * td + r) * 144 + quad * 16), a1 = ldfrag(L, GB_KDT + (16 * td + r) * 144 + 64 + quad * 16);
#pragma unroll
    for (int j = 0; j < 4; ++j) { const int vo = GB_VT + (16 * (te0 + j) + r) * 144 + quad * 16;
        f32x4 acc = {0.f, 0.f, 0.f, 0.f};
        acc = __builtin_amdgcn_mfma_f32_16x16x32_bf16(a0, ldfrag(L, vo), acc, 0, 0, 0);
        acc = __builtin_amdgcn_mfma_f32_16x16x32_bf16(a1, ldfrag(L, vo + 64), acc, 0, 0, 0);
        u[j] = acc; }
}
__device__ __forceinline__ void gla_att(lbytes L, int wv, int r, int quad) {
    const int tt = wv >> 1; const bf16x8 a0 = ldfrag(L, GB_QE + (16 * tt + r) * 144 + quad * 16), a1 = ldfrag(L, GB_QE + (16 * tt + r) * 144 + 64 + quad * 16);
#pragma unroll
    for (int jj = 0; jj < 2; ++jj) { const int ts = 2 * (wv & 1) + jj; f32x4 acc = {0.f, 0.f, 0.f, 0.f};
        if (ts <= tt) { const int ko = GB_KE + (16 * ts + r) * 144 + quad * 16;
            acc = __builtin_amdgcn_mfma_f32_16x16x32_bf16(a0, ldfrag(L, ko), acc, 0, 0, 0);
            acc = __builtin_amdgcn_mfma_f32_16x16x32_bf16(a1, ldfrag(L, ko + 64), acc, 0, 0, 0); }
        LAS unsigned short* at = (LAS unsigned short*)(L + GB_ATT) + (16 * tt + 4 * quad) * 72 + 16 * ts + r;
#pragma unroll
        for (int g = 0; g < 4; ++g) at[g * 72] = bf1((16 * ts + r <= 16 * tt + 4 * quad + g) ? acc[g] : 0.f); }
}
constexpr int GF_BYTES = 9216 + 9216 + 18432;
__device__ __forceinline__ void gla_prep_item(lbytes L, const bf16* PROJ, int idx  , const float* w2l, const float* bl, float* GU, float* GD, unsigned char* GF, int tid) {
    const int c = idx & 127, bh = idx >> 7, b = bh >> 2, h = bh & 3;
    const int wv = __builtin_amdgcn_readfirstlane(tid >> 6), lane = tid & 63, r = lane & 15, quad = lane >> 4;
    gla_front(L, PROJ, b * SEQ + c * 64, 64, h, w2l, bl, tid);
    f32x4 u[4]; gla_U(L, wv, r, quad, u);
    gla_att(L, wv, r, quad);
    const int d0 = 16 * (wv >> 1) + 4 * quad, e0 = 64 * (wv & 1) + r;
#pragma unroll
    for (int j = 0; j < 4; ++j)
#pragma unroll
        for (int g = 0; g < 4; ++g) GU[((size_t)idx * 64 + d0 + g) * 128 + e0 + 16 * j] = u[j][g];
    if (tid < 64) GD[(size_t)idx * 64 + tid] = ((const LAS float*)(L + GB_DV))[tid];
    __syncthreads();
    { GAS v4u* dst = (GAS v4u*)(GF + (size_t)idx * GF_BYTES);
      for (int i = tid; i < GF_BYTES / 16; i += NTHR) { const int off = i < 576 ? GB_QE + i * 16 : i < 1152 ? GB_ATT + (i - 576) * 16 : GB_VT + (i - 1152) * 16; dst[i] = *(const LAS v4u*)(L + off); } }
}
__device__ __forceinline__ void gla_chunk_item(lbytes L, const bf16* PROJ, bf16* MIX, int idx, int l, KArgs a, const float* GU, const unsigned char* GF, int tid) {
    const float* gn = a->in[12] + (size_t)l * 512;
    const int c = idx & 127, bh = idx >> 7, h = bh & 3, r0 = (bh >> 2) * SEQ + c * 64;
    const int wv = __builtin_amdgcn_readfirstlane(tid >> 6), lane = tid & 63, r = lane & 15, quad = lane >> 4;
    const int td = wv >> 1, te0 = (wv & 1) * 4, d0 = 16 * td + 4 * quad, e0 = 64 * (wv & 1) + r;
    __syncthreads();
    v4u img[5]; { const GAS v4u* src = (const GAS v4u*)(GF + (size_t)idx * GF_BYTES);
#pragma unroll
        for (int k = 0; k < 5; ++k) { const int i = tid + k * NTHR; img[k] = i < GF_BYTES / 16 ? src[i] : (v4u){0u, 0u, 0u, 0u}; } }
    f32x4 S[4]; { const float* s0 = GU + (size_t)idx * 8192;
#pragma unroll
        for (int j = 0; j < 4; ++j)
#pragma unroll
            for (int g = 0; g < 4; ++g) S[j][g] = s0[(d0 + g) * 128 + e0 + 16 * j]; }
    unsigned short grv[4][4]; float gnv[4];
#pragma unroll
    for (int j = 0; j < 4; ++j) gnv[j] = gn[h * 128 + e0 + 16 * j];
#pragma unroll
    for (int g = 0; g < 4; ++g) { const bf16* grp = PROJ + (size_t)(r0 + d0 + g) * NIN + C_GR + h * 128 + e0;
#pragma unroll
        for (int j = 0; j < 4; ++j) grv[g][j] = grp[16 * j]; }
#pragma unroll
    for (int k = 0; k < 5; ++k) { const int i = tid + k * NTHR; if (i < GF_BYTES / 16) { const int off = i < 576 ? GB_QE + i * 16 : i < 1152 ? GB_ATT + (i - 576) * 16 : GB_VT + (i - 1152) * 16; *(LAS v4u*)(L + off) = img[k]; } }
#pragma unroll
    for (int j = 0; j < 4; ++j) { u32x2 w; w.x = pkbf(S[j][0], S[j][1]); w.y = pkbf(S[j][2], S[j][3]); *(LAS u32x2*)(L + GB_ST + (e0 + 16 * j) * 144 + d0 * 2) = w; }
    __syncthreads();
    f32x4 o[4];
    { const int ao = (16 * td + r) * 144 + quad * 16;
      const bf16x8 p0 = ldfrag(L, GB_ATT + ao), p1 = ldfrag(L, GB_ATT + ao + 64), q0 = ldfrag(L, GB_QE + ao), q1 = ldfrag(L, GB_QE + ao + 64);
#pragma unroll
      for (int j = 0; j < 4; ++j) { const int bo = (16 * (te0 + j) + r) * 144 + quad * 16; f32x4 acc = {0.f, 0.f, 0.f, 0.f};
          acc = __builtin_amdgcn_mfma_f32_16x16x32_bf16(p0, ldfrag(L, GB_VT + bo), acc, 0, 0, 0);
          acc = __builtin_amdgcn_mfma_f32_16x16x32_bf16(p1, ldfrag(L, GB_VT + bo + 64), acc, 0, 0, 0);
          acc = __builtin_amdgcn_mfma_f32_16x16x32_bf16(q0, ldfrag(L, GB_ST + bo), acc, 0, 0, 0);
          acc = __builtin_amdgcn_mfma_f32_16x16x32_bf16(q1, ldfrag(L, GB_ST + bo + 64), acc, 0, 0, 0);
          o[j] = acc; } }
    { LAS float* SSQ = (LAS float*)(L + GB_SSQ); f32x4 sp;
#pragma unroll
      for (int g = 0; g < 4; ++g) { float s = (o[0][g] * o[0][g] + o[1][g] * o[1][g]) + (o[2][g] * o[2][g] + o[3][g] * o[3][g]); s += shx<1>(s); s += shx<2>(s); s += shx<4>(s); s += shx<8>(s); sp[g] = s; }
      if (r == 0) {
#pragma unroll
          for (int g = 0; g < 4; ++g) SSQ[(d0 + g) * 2 + (wv & 1)] = sp[g]; }
      __syncthreads();
#pragma unroll
      for (int g = 0; g < 4; ++g) { const int t = d0 + g; const float rs = rsqrtf((SSQ[t * 2] + SSQ[t * 2 + 1]) * (1.f / 128.f) + EPS);
          bf16* mp = MIX + (size_t)(r0 + t) * DM + 512 + h * 128 + e0;
#pragma unroll
          for (int j = 0; j < 4; ++j) { const float gr = __uint_as_float(((unsigned)grv[g][j]) << 16); mp[16 * j] = bf1(o[j][g] * rs * gnv[j] * silu_f(gr)); } } }
}
__device__ __forceinline__ void gla_mix_item(lbytes L, const bf16* PROJ, bf16* MIX, int item, int l, KArgs a, const float* GU, const float* GD, int tid) {
    const float* w2l = a->in[10] + (size_t)l * 16 * 256; const float* bl = a->in[11] + (size_t)l * 256; const float* gn = a->in[12] + (size_t)l * 512;
    const int wv = __builtin_amdgcn_readfirstlane(tid >> 6), lane = tid & 63, r = lane & 15, quad = lane >> 4;
    const int td = wv >> 1, te0 = (wv & 1) * 4, d0 = 16 * td + 4 * quad, e0 = 64 * (wv & 1) + r;
    const bool samp = item >= NGLA_P;
    int h, rbase, nch, nrows, sb = 0;
    const float* s0;
    if (!samp) { const int seg = item >> 3, bh = item & 7; h = bh & 3; rbase = (bh >> 2) * SEQ + seg * (64 * GSEG); nch = GSEG; nrows = 64;
        s0 = GU + ((size_t)bh * 128 + seg * GSEG) * 8192; }
    else { const int si = item - NGLA_P; sb = si >> 2; h = si & 3; rbase = MP + sb * DECS; nch = 1; nrows = DECS;
        s0 = a->in[4] + (((size_t)l * DECB + sb) * 4 + h) * 8192; }
    f32x4 S[4];
#pragma unroll
    for (int j = 0; j < 4; ++j)
#pragma unroll
        for (int g = 0; g < 4; ++g) S[j][g] = s0[(d0 + g) * 128 + e0 + 16 * j];
    for (int c = 0; c < nch; ++c) {
        const int r0 = rbase + c * 64;
        gla_front(L, PROJ, r0, nrows, h, w2l, bl, tid);
        f32x4 u[4]; gla_U(L, wv, r, quad, u);
        { const int tt = td; const bf16x8 a0 = ldfrag(L, GB_QE + (16 * tt + r) * 144 + quad * 16), a1 = ldfrag(L, GB_QE + (16 * tt + r) * 144 + 64 + quad * 16);
#pragma unroll
          for (int jj = 0; jj < 2; ++jj) { const int ts = 2 * (wv & 1) + jj; f32x4 acc = {0.f, 0.f, 0.f, 0.f};
              if (ts <= tt) { const int ko = GB_KE + (16 * ts + r) * 144 + quad * 16;
                  acc = __builtin_amdgcn_mfma_f32_16x16x32_bf16(a0, ldfrag(L, ko), acc, 0, 0, 0);
                  acc = __builtin_amdgcn_mfma_f32_16x16x32_bf16(a1, ldfrag(L, ko + 64), acc, 0, 0, 0); }
              LAS unsigned short* at = (LAS unsigned short*)(L + GB_ATT) + (16 * tt + 4 * quad) * 72 + 16 * ts + r;
#pragma unroll
              for (int g = 0; g < 4; ++g) at[g * 72] = bf1((16 * ts + r <= 16 * tt + 4 * quad + g) ? acc[g] : 0.f); } }
#pragma unroll
        for (int j = 0; j < 4; ++j) { u32x2 w; w.x = pkbf(S[j][0], S[j][1]); w.y = pkbf(S[j][2], S[j][3]); *(LAS u32x2*)(L + GB_ST + (e0 + 16 * j) * 144 + d0 * 2) = w; }
        __syncthreads();
        f32x4 o[4];
        { const int ao = (16 * td + r) * 144 + quad * 16;
          const bf16x8 p0 = ldfrag(L, GB_ATT + ao), p1 = ldfrag(L, GB_ATT + ao + 64), q0 = ldfrag(L, GB_QE + ao), q1 = ldfrag(L, GB_QE + ao + 64);
#pragma unroll
          for (int j = 0; j < 4; ++j) { const int bo = (16 * (te0 + j) + r) * 144 + quad * 16; f32x4 acc = {0.f, 0.f, 0.f, 0.f};
              acc = __builtin_amdgcn_mfma_f32_16x16x32_bf16(p0, ldfrag(L, GB_VT + bo), acc, 0, 0, 0);
              acc = __builtin_amdgcn_mfma_f32_16x16x32_bf16(p1, ldfrag(L, GB_VT + bo + 64), acc, 0, 0, 0);
              acc = __builtin_amdgcn_mfma_f32_16x16x32_bf16(q0, ldfrag(L, GB_ST + bo), acc, 0, 0, 0);
              acc = __builtin_amdgcn_mfma_f32_16x16x32_bf16(q1, ldfrag(L, GB_ST + bo + 64), acc, 0, 0, 0);
              o[j] = acc; } }
        { LAS float* SSQ = (LAS float*)(L + GB_SSQ); f32x4 sp;
#pragma unroll
          for (int g = 0; g < 4; ++g) { float s = (o[0][g] * o[0][g] + o[1][g] * o[1][g]) + (o[2][g] * o[2][g] + o[3][g] * o[3][g]); s += shx<1>(s); s += shx<2>(s); s += shx<4>(s); s += shx<8>(s); sp[g] = s; }
          if (r == 0) {
#pragma unroll
              for (int g = 0; g < 4; ++g) SSQ[(d0 + g) * 2 + (wv & 1)] = sp[g]; }
          __syncthreads();
          unsigned short grv[4][4]; float gnv[4];
#pragma unroll
          for (int j = 0; j < 4; ++j) gnv[j] = gn[h * 128 + e0 + 16 * j];
#pragma unroll
          for (int g = 0; g < 4; ++g) { const int t = (d0 + g < nrows) ? d0 + g : 0; const bf16* grp = PROJ + (size_t)(r0 + t) * NIN + C_GR + h * 128 + e0;
#pragma unroll
              for (int j = 0; j < 4; ++j) grv[g][j] = grp[16 * j]; }
#pragma unroll
          for (int g = 0; g < 4; ++g) { const int t = d0 + g; const float rs = rsqrtf((SSQ[t * 2] + SSQ[t * 2 + 1]) * (1.f / 128.f) + EPS);
              if (t < nrows) { bf16* mp = MIX + (size_t)(r0 + t) * DM + 512 + h * 128 + e0;
#pragma unroll
                  for (int j = 0; j < 4; ++j) { const float gr = __uint_as_float(((unsigned)grv[g][j]) << 16); mp[16 * j] = bf1(o[j][g] * rs * gnv[j] * silu_f(gr)); } } } }
        { const f32x4 dv = *(const LAS f32x4*)(L + GB_DV + d0 * 4);
#pragma unroll
          for (int j = 0; j < 4; ++j) { S[j][0] = dv.x * S[j][0] + u[j][0]; S[j][1] = dv.y * S[j][1] + u[j][1]; S[j][2] = dv.z * S[j][2] + u[j][2]; S[j][3] = dv.w * S[j][3] + u[j][3]; } }
    }
    if (samp) { float* so = a->out + O_GS + (((size_t)l * DECB + sb) * 4 + h) * 8192;
#pragma unroll
        for (int j = 0; j < 4; ++j)
#pragma unroll
            for (int g = 0; g < 4; ++g) so[(d0 + g) * 128 + e0 + 16 * j] = S[j][g]; }
}
__device__ __forceinline__ void gla_scan_item(float* GU, const float* GD, float* outS  , int e) {
    {
        const int bh = e >> 13, el = e & 8191, d = el >> 7;
        float* up = GU + (size_t)bh * 128 * 8192 + el; const float* dp = GD + (size_t)bh * 128 * 64 + d;
        float s0 = 0.f, s1 = 0.f, s2 = 0.f, s3 = 0.f, p0 = 1.f, p1 = 1.f, p2 = 1.f;
#pragma unroll 4
        for (int c = 0; c < 32; ++c) {
            const float u0 = up[(size_t)c * 8192], u1 = up[(size_t)(32 + c) * 8192], u2 = up[(size_t)(64 + c) * 8192], u3 = up[(size_t)(96 + c) * 8192];
            const float d0 = dp[c * 64], d1 = dp[(32 + c) * 64], d2 = dp[(64 + c) * 64], d3 = dp[(96 + c) * 64];
            s0 = d0 * s0 + u0; s1 = d1 * s1 + u1; s2 = d2 * s2 + u2; s3 = d3 * s3 + u3; p0 *= d0; p1 *= d1; p2 *= d2; (void)d3; }
        float t0 = 0.f, t1 = s0, t2 = p1 * t1 + s1, t3 = p2 * t2 + s2; (void)p0; (void)s3;
        float uc[4][4], dc[4][4], un[4][4], dn[4][4];
#pragma unroll
        for (int k = 0; k < 4; ++k)
#pragma unroll
            for (int q = 0; q < 4; ++q) { uc[k][q] = up[(size_t)(32 * q + k) * 8192]; dc[k][q] = dp[(32 * q + k) * 64]; }
        for (int blk = 0; blk < 8; ++blk) {
            const int cn = (blk < 7 ? blk + 1 : blk) * 4;
#pragma unroll
            for (int k = 0; k < 4; ++k)
#pragma unroll
                for (int q = 0; q < 4; ++q) { un[k][q] = up[(size_t)(32 * q + cn + k) * 8192]; dn[k][q] = dp[(32 * q + cn + k) * 64]; }
#pragma unroll
            for (int k = 0; k < 4; ++k) { const int c = blk * 4 + k;
                up[(size_t)c * 8192] = t0; up[(size_t)(32 + c) * 8192] = t1; up[(size_t)(64 + c) * 8192] = t2; up[(size_t)(96 + c) * 8192] = t3;
                t0 = dc[k][0] * t0 + uc[k][0]; t1 = dc[k][1] * t1 + uc[k][1]; t2 = dc[k][2] * t2 + uc[k][2]; t3 = dc[k][3] * t3 + uc[k][3]; }
#pragma unroll
            for (int k = 0; k < 4; ++k)
#pragma unroll
                for (int q = 0; q < 4; ++q) { uc[k][q] = un[k][q]; dc[k][q] = dn[k][q]; }
        }
        outS[e] = t3;
    }
}

constexpr int CB_W = 0;
constexpr int CB_VT = 128 * 272;
static_assert(CB_VT + 128 * 272 <= SCR_BYTES, "cm lds");
__device__ __forceinline__ void cm_item(lbytes L, const bf16* PROJ, bf16* MIX, int item, int l, KArgs a, int tid) {
    int r0, g, nrows;
    if (item < 512) { g = item & 3; const int bn = item >> 2; r0 = (bn >> 6) * SEQ + (bn & 63) * 128; nrows = 128; }
    else { const int si = item - 512; g = si & 3; r0 = MP + (si >> 2) * DECS; nrows = DECS; }
    const float* Wg = a->in[8] + ((size_t)l * 4 + g) * 128 * 128; const float* bg = a->in[9] + ((size_t)l * 4 + g) * 128;
    __syncthreads();
    { const int j = tid >> 2, c0 = (tid & 3) * 32; float x[16], y[16];
      { const GAS f32x4* wp = (const GAS f32x4*)(Wg + (size_t)j * 128 + c0); LAS v4u* wd = (LAS v4u*)(L + CB_W + j * 272 + c0 * 2);
#pragma unroll
        for (int q = 0; q < 4; ++q) { const f32x4 w0 = wp[2 * q], w1 = wp[2 * q + 1]; v4u o; o.x = pkbf(w0.x, w0.y); o.y = pkbf(w0.z, w0.w); o.z = pkbf(w1.x, w1.y); o.w = pkbf(w1.z, w1.w); wd[q] = o; } }
      if (j < nrows) { const GAS v4u* p = (const GAS v4u*)(PROJ + (size_t)(r0 + j) * NIN + C_CV + g * 128 + c0); unpack16(p[0], p[1], x); unpack16(p[2], p[3], y); } else {
#pragma unroll
          for (int i = 0; i < 16; ++i) { x[i] = 0.f; y[i] = 0.f; } }
      float s = 0.f;
#pragma unroll
      for (int i = 0; i < 16; ++i) { x[i] = gelu_t(x[i]); y[i] = gelu_t(y[i]); s += x[i] + y[i]; }
      s += shx<1>(s); s += shx<2>(s);
      const float mu = s * (1.f / 128.f); float q = 0.f;
#pragma unroll
      for (int i = 0; i < 16; ++i) { x[i] -= mu; y[i] -= mu; q += x[i] * x[i] + y[i] * y[i]; }
      q += shx<1>(q); q += shx<2>(q);
      const float rs = (j < nrows) ? rsqrtf(q * (1.f / 128.f) + EPS) : 0.f;
#pragma unroll
      for (int i = 0; i < 16; ++i) { x[i] *= rs; y[i] *= rs; }
      LAS unsigned short* vt = (LAS unsigned short*)(L + CB_VT) + c0 * 136 + j;
#pragma unroll
      for (int i = 0; i < 16; ++i) { vt[i * 136] = bf1(x[i]); vt[(16 + i) * 136] = bf1(y[i]); }
      if (item >= 512 && j < nrows) { GAS f32x4* o4 = (GAS f32x4*)(a->out + O_CM + ((size_t)l * MS + (r0 - MP) + j) * 512 + g * 128 + c0);
#pragma unroll
          for (int i = 0; i < 4; ++i) { o4[i] = (f32x4){x[4 * i], x[4 * i + 1], x[4 * i + 2], x[4 * i + 3]}; o4[4 + i] = (f32x4){y[4 * i], y[4 * i + 1], y[4 * i + 2], y[4 * i + 3]}; } } }
    __syncthreads();
    const int wv = __builtin_amdgcn_readfirstlane(tid >> 6), lane = tid & 63, r = lane & 15, quad = lane >> 4;
#pragma unroll
    for (int half = 0; half < 2; ++half) {
        const int ti = half * 4 + (wv >> 1);
        if (16 * ti < nrows) {
            f32x4 acc[4];
#pragma unroll
            for (int jc = 0; jc < 4; ++jc) acc[jc] = (f32x4){0.f, 0.f, 0.f, 0.f};
#pragma unroll
            for (int k = 0; k < 4; ++k) { if (half == 0 && k >= 2) break;
                const bf16x8 af = ldfrag(L, CB_W + (16 * ti + r) * 272 + k * 64 + quad * 16);
#pragma unroll
                for (int jc = 0; jc < 4; ++jc) acc[jc] = __builtin_amdgcn_mfma_f32_16x16x32_bf16(af, ldfrag(L, CB_VT + (16 * (4 * (wv & 1) + jc) + r) * 272 + k * 64 + quad * 16), acc[jc], 0, 0, 0); }
            const int cc = g * 128 + 64 * (wv & 1) + r;
            unsigned short uv[4][4]; float bbv[4];
#pragma unroll
            for (int gq = 0; gq < 4; ++gq) { int ii = 16 * ti + 4 * quad + gq; if (ii >= nrows) ii = 0; bbv[gq] = bg[ii]; const bf16* up = PROJ + (size_t)(r0 + ii) * NIN + C_CU + cc;
#pragma unroll
                for (int jc = 0; jc < 4; ++jc) uv[gq][jc] = up[16 * jc]; }
#pragma unroll
            for (int gq = 0; gq < 4; ++gq) { const int ii = 16 * ti + 4 * quad + gq;
                if (ii < nrows) { bf16* mp = MIX + (size_t)(r0 + ii) * DM + cc;
#pragma unroll
                    for (int jc = 0; jc < 4; ++jc) { const float uu = __uint_as_float(((unsigned)uv[gq][jc]) << 16); mp[16 * jc] = bf1(gelu_t(uu) * (acc[jc][gq] + bbv[gq])); } } }
        }
    }
}

constexpr int SA_Q = 0, SA_K = 16 * 128, SA_V = SA_K + 64 * 132, SA_A = SA_V + 64 * 132;
static_assert((SA_A + 16 * 64 + 8) * 4 <= SCR_BYTES, "sa lds");
__device__ __forceinline__ float sfx32(float x, int j, int lane) {
#pragma unroll
    for (int o = 1; o < 32; o <<= 1) { const float y = bperm(x, lane + o); x *= (j + o < 32) ? y : 1.f; }
    return x;
}
__device__ __forceinline__ void sattn_item(LAS float* L, const bf16* PROJ, bf16* MIX, int item, int l, KArgs a, int tid) {
    const int sb = item >> 3, h = item & 7, rq = MP + sb * DECS;
    const int i = tid >> 5, j = tid & 31;
    __syncthreads();
    { const int qi = tid >> 5, d4 = (tid & 31) * 4; const u32x2 w = *(const GAS u32x2*)(PROJ + (size_t)(rq + qi) * NIN + C_SQ + h * 128 + d4);
      f32x4 x = {bf_lo(w.x), bf_hi(w.x), bf_lo(w.y), bf_hi(w.y)}; float ss = (x.x * x.x + x.y * x.y) + (x.z * x.z + x.w * x.w);
      ss += shx<1>(ss); ss += shx<2>(ss); ss += shx<4>(ss); ss += shx<8>(ss); ss += shx<16>(ss);
      const f32x4 gg = *(const GAS f32x4*)(a->in[13] + (size_t)l * 128 + d4);
      *(LAS f32x4*)(L + SA_Q + qi * 128 + d4) = x * (rsqrtf(ss * (1.f / 128.f) + EPS) * QSCALE) * gg; }
    f32x4 o = {0.f, 0.f, 0.f, 0.f}; float carry = 1.f;
    const float* ck = a->in[2] + ((size_t)l * DECB + sb) * PAST * 1024 + h * 128; const float* cv = a->in[3] + ((size_t)l * DECB + sb) * PAST * 1024 + h * 128;
    for (int blk = 32; blk >= 0; --blk) {
        __syncthreads();
        { const int key = tid >> 3, c = tid & 7;
          if (blk == 32) {
              float kx[16], vx[16];
              if (key < DECS) { const bf16* prow = PROJ + (size_t)(rq + key) * NIN + h * 128 + c * 16; const GAS v4u* pk = (const GAS v4u*)(prow + C_SK); const GAS v4u* pv = (const GAS v4u*)(prow + C_SV);
                  unpack16(pk[0], pk[1], kx); unpack16(pv[0], pv[1], vx); } else {
#pragma unroll
                  for (int t = 0; t < 16; ++t) { kx[t] = 0.f; vx[t] = 0.f; } }
              { float ss = 0.f;
#pragma unroll
                for (int t = 0; t < 16; ++t) ss += kx[t] * kx[t];
                ss += shx<1>(ss); ss += shx<2>(ss); ss += shx<4>(ss);
                const float rs = rsqrtf(ss * (1.f / 128.f) + EPS); const GAS f32x4* g4 = (const GAS f32x4*)(a->in[14] + (size_t)l * 128 + c * 16);
#pragma unroll
                for (int t = 0; t < 4; ++t) { const f32x4 gg = g4[t]; kx[4 * t] *= rs * gg.x; kx[4 * t + 1] *= rs * gg.y; kx[4 * t + 2] *= rs * gg.z; kx[4 * t + 3] *= rs * gg.w; }
                if (key < DECS) { GAS f32x4* o4 = (GAS f32x4*)(a->out + O_KS + ((size_t)l * MS + sb * DECS + key) * 1024 + h * 128 + c * 16);
#pragma unroll
                    for (int t = 0; t < 4; ++t) o4[t] = (f32x4){kx[4 * t], kx[4 * t + 1], kx[4 * t + 2], kx[4 * t + 3]}; } }
              LAS f32x4* dk = (LAS f32x4*)(L + SA_K + key * 132 + c * 16); LAS f32x4* dv = (LAS f32x4*)(L + SA_V + key * 132 + c * 16);
#pragma unroll
              for (int t = 0; t < 4; ++t) { dk[t] = (f32x4){kx[4 * t], kx[4 * t + 1], kx[4 * t + 2], kx[4 * t + 3]}; dv[t] = (f32x4){vx[4 * t], vx[4 * t + 1], vx[4 * t + 2], vx[4 * t + 3]}; }
          } else {
              const size_t off = (size_t)(blk * 64 + key) * 1024;
#pragma unroll
              for (int t = 0; t < 4; ++t) { const int d = t * 32 + c * 4;
                  *(LAS f32x4*)(L + SA_K + key * 132 + d) = *(const GAS f32x4*)(ck + off + d); *(LAS f32x4*)(L + SA_V + key * 132 + d) = *(const GAS f32x4*)(cv + off + d); }
          } }
        __syncthreads();
        float zl = 0.f, zh = 0.f;
        { const LAS f32x4* q4 = (const LAS f32x4*)(L + SA_Q + i * 128); const LAS f32x4* kl = (const LAS f32x4*)(L + SA_K + j * 132); const LAS f32x4* kh = (const LAS f32x4*)(L + SA_K + (j + 32) * 132);
#pragma unroll 8
          for (int d = 0; d < 32; ++d) { const f32x4 q = q4[d], x = kl[d], y = kh[d]; zl += (q.x * x.x + q.y * x.y) + (q.z * x.z + q.w * x.w); zh += (q.x * y.x + q.y * y.y) + (q.z * y.z + q.w * y.w); } }
        const bool vl = (blk < 32) || (j < i), vh = (blk < 32);
        const float el = __builtin_amdgcn_exp2f(zl), eh = __builtin_amdgcn_exp2f(zh), rl = __builtin_amdgcn_rcpf(1.f + el), rh = __builtin_amdgcn_rcpf(1.f + eh);
        const float stl = vl ? rl : 1.f, sth = vh ? rh : 1.f, bl_ = vl ? el * rl : 0.f, bh_ = vh ? eh * rh : 0.f;
        const int lane = tid & 63; const float xh = sfx32(sth, j, lane), xl = sfx32(stl, j, lane);
        float eh_x = bperm(xh, lane + 1); eh_x = (j < 31) ? eh_x : 1.f;
        float el_x = bperm(xl, lane + 1); el_x = (j < 31) ? el_x : 1.f;
        const float totH = bperm(xh, lane & 32), totL = bperm(xl, lane & 32);
        L[SA_A + i * 64 + 32 + j] = bh_ * eh_x * carry;
        L[SA_A + i * 64 + j] = bl_ * el_x * totH * carry;
        carry = carry * totH * totL;
        if ((tid & 63) == 0) L[SA_A + 1024 + (tid >> 6)] = __all(carry == 0.f) ? 1.f : 0.f;
        __syncthreads();
        { const int d4 = j * 4; const LAS float* ap = L + SA_A + i * 64;
#pragma unroll 8
          for (int s = 0; s < 64; ++s) { const float p = ap[s]; const f32x4 v4 = *(const LAS f32x4*)(L + SA_V + s * 132 + d4); o += p * v4; } }
        { const f32x4 f0 = *(const LAS f32x4*)(L + SA_A + 1024), f1 = *(const LAS f32x4*)(L + SA_A + 1028); if ((f0.x * f0.y) * (f0.z * f0.w) * (f1.x * f1.y) * (f1.z * f1.w) != 0.f) break; }
    }
    { u32x2 w; w.x = pkbf(o.x, o.y); w.y = pkbf(o.z, o.w); *(GAS u32x2*)(MIX + (size_t)(rq + i) * DM + 1024 + h * 128 + j * 4) = w; }
}

namespace att {
typedef short s16x4 __attribute__((ext_vector_type(4)));
typedef float f32x16 __attribute__((ext_vector_type(16)));
constexpr int SHM_V = 64 * 128 * 2, SHM_K = 64 * 128 * 2;
#define KSWZ(row, colB) ((row) * 256 + ((colB) ^ (((row) & 7) << 4)))
#define SBAR() __builtin_amdgcn_sched_barrier(0)
__device__ __forceinline__ int v_st(int k, int c) { const int kk = (k & ~0xC) | ((k & 4) << 1) | ((k & 8) >> 1); return ((kk >> 3) * 4 + (c >> 5)) * 512 + ((kk & 7) * 32 + (c & 31)) * 2; }
__device__ __forceinline__ int v_rd_base(int lane) { return ((lane & 3) << 3) | (((lane >> 2) & 3) << 6) | (((lane >> 4) & 1) << 5) | (((lane >> 5) & 1) << 8); }
constexpr int v_rd_off(int d0, int ks, int half) { return d0 * 512 + ks * 4096 + half * 2048; }
__device__ __forceinline__ int crow(int r, int hi) { return (r & 3) + 8 * (r >> 2) + 4 * hi; }
__device__ __forceinline__ void qkt(f32x16& p0, f32x16& p1, const char* K_lds, int r32, int hi, const bf16x8* qr) {
    p0 = f32x16{}; p1 = f32x16{};
    const char* kb[4];
#pragma unroll
    for (int dd = 0; dd < 4; ++dd) kb[dd] = K_lds + KSWZ(r32, (dd * 16 + hi * 8) * 2);
#pragma unroll
    for (int d0 = 0; d0 < 8; ++d0) { const char* a = kb[d0 & 3] + (d0 >> 2) * 128;
        bf16x8 b0 = *reinterpret_cast<const bf16x8*>(a);
        bf16x8 b1 = *reinterpret_cast<const bf16x8*>(a + 32 * 256);
        p0 = __builtin_amdgcn_mfma_f32_32x32x16_bf16(b0, qr[d0], p0, 0, 0, 0);
        p1 = __builtin_amdgcn_mfma_f32_32x32x16_bf16(b1, qr[d0], p1, 0, 0, 0); }
}
__device__ __forceinline__ void pv_tile(f32x16* o, int vb0, bf16x8 pa0, bf16x8 pa1, bf16x8 pa2, bf16x8 pa3) {
#define TRRD(dst, off) asm volatile("ds_read_b64_tr_b16 %0, %1 offset:%2" : "=&v"(dst) : "v"(vb0), "i"(off) : "memory")
#define PV_D0(d0) do { s16x4 l0, l1, l2, l3, h0, h1, h2, h3; constexpr int b_ = v_rd_off(d0, 0, 0); \
        TRRD(l0, b_); TRRD(h0, b_ + 2048); TRRD(l1, b_ + 4096); TRRD(h1, b_ + 6144); TRRD(l2, b_ + 8192); TRRD(h2, b_ + 10240); TRRD(l3, b_ + 12288); TRRD(h3, b_ + 14336); \
        asm volatile("s_waitcnt lgkmcnt(0)" ::: "memory"); SBAR(); \
        o[d0] = __builtin_amdgcn_mfma_f32_32x32x16_bf16(pa0, (bf16x8){l0[0], l0[1], l0[2], l0[3], h0[0], h0[1], h0[2], h0[3]}, o[d0], 0, 0, 0); \
        o[d0] = __builtin_amdgcn_mfma_f32_32x32x16_bf16(pa1, (bf16x8){l1[0], l1[1], l1[2], l1[3], h1[0], h1[1], h1[2], h1[3]}, o[d0], 0, 0, 0); \
        o[d0] = __builtin_amdgcn_mfma_f32_32x32x16_bf16(pa2, (bf16x8){l2[0], l2[1], l2[2], l2[3], h2[0], h2[1], h2[2], h2[3]}, o[d0], 0, 0, 0); \
        o[d0] = __builtin_amdgcn_mfma_f32_32x32x16_bf16(pa3, (bf16x8){l3[0], l3[1], l3[2], l3[3], h3[0], h3[1], h3[2], h3[3]}, o[d0], 0, 0, 0); } while (0)
    PV_D0(0); PV_D0(1); PV_D0(2); PV_D0(3);
#undef PV_D0
#undef TRRD
}
template <bool MASK>
__device__ __forceinline__ void sb_tile(f32x16& p0, f32x16& p1, float& carry, int hi, int dq  ) {
#pragma unroll
    for (int r = 0; r < 16; ++r) { const int c = (r & 3) + 8 * (r >> 2);
        { const float e = __builtin_amdgcn_exp2f(p0[r]); p0[r] = (!MASK || (c < dq)) ? e : 0.f; }
        { const float e = __builtin_amdgcn_exp2f(p1[r]); p1[r] = (!MASK || (c + 32 < dq)) ? e : 0.f; } }
    float pp[8], pt[8], rk[8];
#pragma unroll
    for (int k = 0; k < 4; ++k) {
        { const float g = ((1.f + p0[4 * k]) * (1.f + p0[4 * k + 1])) * ((1.f + p0[4 * k + 2]) * (1.f + p0[4 * k + 3])); const float rg = __builtin_amdgcn_rcpf(g); rk[k] = rg;
          auto rr = __builtin_amdgcn_permlane32_swap(__float_as_uint(rg), __float_as_uint(rg), false, false);
          const float r0 = __uint_as_float(rr[0]), r1 = __uint_as_float(rr[1]); pp[k] = r0 * r1; pt[k] = hi ? 1.f : r1; }
        { const float g = ((1.f + p1[4 * k]) * (1.f + p1[4 * k + 1])) * ((1.f + p1[4 * k + 2]) * (1.f + p1[4 * k + 3])); const float rg = __builtin_amdgcn_rcpf(g); rk[4 + k] = rg;
          auto rr = __builtin_amdgcn_permlane32_swap(__float_as_uint(rg), __float_as_uint(rg), false, false);
          const float r0 = __uint_as_float(rr[0]), r1 = __uint_as_float(rr[1]); pp[4 + k] = r0 * r1; pt[4 + k] = hi ? 1.f : r1; } }
    float pe = carry; float one = 1.f; asm volatile("" : "+v"(one));
#pragma unroll
    for (int k = 7; k >= 0; --k) { const float x = pe * pt[k]; pe *= pp[k];
        if (k >= 4) { const int b = 4 * (k - 4); const float i0 = x * rk[k], i1 = i0 * (one + p1[b]), i2 = i1 * (one + p1[b + 1]), i3 = i2 * (one + p1[b + 2]);
            p1[b] *= i0; p1[b + 1] *= i1; p1[b + 2] *= i2; p1[b + 3] *= i3; }
        else { const int b = 4 * k; const float i0 = x * rk[k], i1 = i0 * (one + p0[b]), i2 = i1 * (one + p0[b + 1]), i3 = i2 * (one + p0[b + 2]);
            p0[b] *= i0; p0[b + 1] *= i1; p0[b + 2] *= i2; p0[b + 3] *= i3; } }
    carry = pe;
}
#define PK4(P, B_, OUT) do { unsigned a0 = pkbf(P[B_ + 0], P[B_ + 1]), a1 = pkbf(P[B_ + 2], P[B_ + 3]); \
        unsigned b0 = pkbf(P[B_ + 4], P[B_ + 5]), b1 = pkbf(P[B_ + 6], P[B_ + 7]); \
        auto r0 = __builtin_amdgcn_permlane32_swap(a0, b0, false, false); auto r1 = __builtin_amdgcn_permlane32_swap(a1, b1, false, false); \
        v4u w = {r0[0], r1[0], r0[1], r1[1]}; OUT = *reinterpret_cast<bf16x8*>(&w); } while (0)

__device__ __forceinline__ void attn_item(char* lds, const bf16* PROJ, bf16* MIX, int b, int h, int qb, int tid, const float* __restrict__ gq, const float* __restrict__ gk, float* kout  ) {
    const int wid = __builtin_amdgcn_readfirstlane(tid >> 6), lane = tid & 63, r32 = lane & 31, hi = lane >> 5;
    char* V_lds = lds; char* K_lds = lds + 2 * SHM_V;
    const int P0 = qb * 256, rowbase = b * SEQ, qlo = P0 + wid * 32, qpos = qlo + r32;
    bf16x8 qr[8];
    { const bf16* qp = PROJ + (size_t)(rowbase + qpos) * NIN + C_SQ + h * 128 + hi * 8;
      v4u raw[8]; float ss = 0.f;
#pragma unroll
      for (int d0 = 0; d0 < 8; ++d0) raw[d0] = *reinterpret_cast<const v4u*>(qp + d0 * 16);
#pragma unroll
      for (int d0 = 0; d0 < 8; ++d0) { float x[8]; unpack8(raw[d0], x);
#pragma unroll
          for (int i = 0; i < 8; ++i) ss += x[i] * x[i]; }
      ss = sum_x32(ss);
      const float rs = rsqrtf(ss * (1.f / 128.f) + EPS) * QSCALE;
#pragma unroll
      for (int d0 = 0; d0 < 8; ++d0) { float x[8]; unpack8(raw[d0], x); const f32x4 g0 = *(const GAS f32x4*)(gq + d0 * 16 + hi * 8), g1 = *(const GAS f32x4*)(gq + d0 * 16 + hi * 8 + 4);
          x[0] *= rs * g0.x; x[1] *= rs * g0.y; x[2] *= rs * g0.z; x[3] *= rs * g0.w; x[4] *= rs * g1.x; x[5] *= rs * g1.y; x[6] *= rs * g1.z; x[7] *= rs * g1.w;
          const v4u w = pack8f(x); qr[d0] = *reinterpret_cast<const bf16x8*>(&w); } }
    f32x16 o[4] = {};
    float carry = 1.f;
    const int sr = tid >> 4, sc = (tid & 15) * 8, vst0 = v_st(sr, sc), vst1 = v_st(32 + sr, sc), kws = KSWZ(sr, sc * 2);
    const int vb0 = (int)(uintptr_t)V_lds + v_rd_base(lane);
    volatile LAS int* dn = (volatile LAS int*)(lds + 2 * SHM_V + 2 * SHM_K);
    bool wdone = false;
    const bf16* kvp = PROJ + (size_t)(rowbase + sr) * NIN + C_SK + h * 128 + sc;
    bf16x8 sk0, sk1, sv0, sv1;
    { const bf16* kp = kvp + (size_t)((4 * qb + 3) * 64) * NIN;
      sk0 = *reinterpret_cast<const bf16x8*>(kp); sk1 = *reinterpret_cast<const bf16x8*>(kp + (size_t)32 * NIN);
      sv0 = *reinterpret_cast<const bf16x8*>(kp + (C_SV - C_SK)); sv1 = *reinterpret_cast<const bf16x8*>(kp + (size_t)32 * NIN + (C_SV - C_SK)); }
    for (int jt = 4 * qb + 3; jt >= 0; --jt) {
        const int kb0 = jt * 64;
        __syncthreads();
        {
          float gk8[8]; { const f32x4 g0 = *(const GAS f32x4*)(gk + (tid & 15) * 8), g1 = *(const GAS f32x4*)(gk + (tid & 15) * 8 + 4); gk8[0] = g0.x; gk8[1] = g0.y; gk8[2] = g0.z; gk8[3] = g0.w; gk8[4] = g1.x; gk8[5] = g1.y; gk8[6] = g1.z; gk8[7] = g1.w; }
          float x0[8], x1[8]; unpack8(*reinterpret_cast<const v4u*>(&sk0), x0); unpack8(*reinterpret_cast<const v4u*>(&sk1), x1); float s0 = 0.f, s1 = 0.f;
#pragma unroll
          for (int i = 0; i < 8; ++i) { s0 += x0[i] * x0[i]; s1 += x1[i] * x1[i]; }
          s0 += shx<1>(s0); s0 += shx<2>(s0); s0 += shx<4>(s0); s0 += shx<8>(s0); s1 += shx<1>(s1); s1 += shx<2>(s1); s1 += shx<4>(s1); s1 += shx<8>(s1);
          const float r0 = rsqrtf(s0 * (1.f / 128.f) + EPS), r1 = rsqrtf(s1 * (1.f / 128.f) + EPS);
#pragma unroll
          for (int i = 0; i < 8; ++i) { x0[i] *= r0 * gk8[i]; x1[i] *= r1 * gk8[i]; }
          const v4u w0 = pack8f(x0), w1 = pack8f(x1);
          *(v4u*)(K_lds + kws) = w0; *(v4u*)(K_lds + kws + 32 * 256) = w1; *(bf16x8*)(V_lds + vst0) = sv0; *(bf16x8*)(V_lds + vst1) = sv1;
          if (jt > 0) { const bf16* kp = kvp + (size_t)(kb0 - 64) * NIN;
            sk0 = *reinterpret_cast<const bf16x8*>(kp); sk1 = *reinterpret_cast<const bf16x8*>(kp + (size_t)32 * NIN);
            sv0 = *reinterpret_cast<const bf16x8*>(kp + (C_SV - C_SK)); sv1 = *reinterpret_cast<const bf16x8*>(kp + (size_t)32 * NIN + (C_SV - C_SK)); }
          if (jt >= 4 * qb) { float* kp0 = kout + (size_t)(rowbase + kb0 + sr) * 1024 + h * 128 + sc;
              __builtin_nontemporal_store((f32x4){x0[0], x0[1], x0[2], x0[3]}, (f32x4*)kp0); __builtin_nontemporal_store((f32x4){x0[4], x0[5], x0[6], x0[7]}, (f32x4*)(kp0 + 4));
              __builtin_nontemporal_store((f32x4){x1[0], x1[1], x1[2], x1[3]}, (f32x4*)(kp0 + 32 * 1024)); __builtin_nontemporal_store((f32x4){x1[4], x1[5], x1[6], x1[7]}, (f32x4*)(kp0 + 32 * 1024 + 4)); } }
        if (lane == 0) dn[wid] = wdone ? 1 : 0;
        __syncthreads();
        { const int a0 = dn[0] & dn[1] & dn[2] & dn[3], a1 = dn[4] & dn[5] & dn[6] & dn[7]; if (a0 & a1) break; }
        if (kb0 < qlo + 31 && !wdone) {
            f32x16 p0, p1;
            qkt(p0, p1, K_lds, r32, hi, qr);
            if (kb0 + 63 >= qlo) sb_tile<true>(p0, p1, carry, hi, qpos - kb0 - 4 * hi); else sb_tile<false>(p0, p1, carry, hi, 0);
            bf16x8 pa0, pa1, pa2, pa3;
            PK4(p0, 0, pa0); PK4(p0, 8, pa1); PK4(p1, 0, pa2); PK4(p1, 8, pa3);
            pv_tile(o, vb0, pa0, pa1, pa2, pa3);
            wdone = __all(carry == 0.f) != 0;
        }
    }
    bf16* Ow = MIX + (size_t)(rowbase + qlo) * DM + 1024 + h * 128;
#pragma unroll
    for (int r = 0; r < 16; ++r) { const int orow = crow(r, hi);
#pragma unroll
        for (int d0 = 0; d0 < 4; ++d0) { const float v = o[d0][r]; const float vn = shx<1>(v);
            if ((r32 & 1) == 0) *(unsigned*)(Ow + (size_t)orow * DM + d0 * 32 + r32) = pkbf(v, vn); } }
}
#undef PK4
#undef KSWZ
#undef SBAR
}

__device__ __forceinline__ void conv_fix_phase(const float* GH, const float* SBR, bf16* HID, const float* PGU, const float* SS2, int l, KArgs a, int gtid, int GT) {
    const float* cw = a->in[19] + (size_t)l * 3 * FF; const float* cb = a->in[20] + (size_t)l * FF;
    constexpr int NF4 = FF / 4;
    for (int idx = gtid; idx < MS * NF4; idx += GT) {
        const int rs = idx / NF4, f = (idx - rs * NF4) * 4, i = rs & 15, sb = rs >> 4, col = (f >> 7) * 256 + (f & 127);
        f32x4 g2 = {0.f, 0.f, 0.f, 0.f}, g1 = g2, g0 = g2, uu = g2;
#pragma unroll
        for (int p = 0; p < NP_GU; ++p) { const float* pp = PGU + ((size_t)p * 128 + rs) * NGU + col;
            g2 += *(const GAS f32x4*)pp; uu += *(const GAS f32x4*)(pp + 128);
            if (i >= 1) g1 += *(const GAS f32x4*)(pp - NGU); if (i >= 2) g0 += *(const GAS f32x4*)(pp - 2 * NGU); }
        const float r2 = rsqrtf(SS2[MP + rs] * (1.f / DM) + EPS); g2 *= r2; uu *= r2;
        const float* st = a->in[5] + ((size_t)l * DECB + sb) * 2 * FF + f;
        if (i >= 1) g1 *= rsqrtf(SS2[MP + rs - 1] * (1.f / DM) + EPS); else g1 = *(const GAS f32x4*)(st + FF);
        if (i >= 2) g0 *= rsqrtf(SS2[MP + rs - 2] * (1.f / DM) + EPS); else g0 = *(const GAS f32x4*)(st + (i == 0 ? 0 : FF));
        const f32x4 w0 = *(const GAS f32x4*)(cw + f), w1 = *(const GAS f32x4*)(cw + FF + f), w2 = *(const GAS f32x4*)(cw + 2 * FF + f), bb = *(const GAS f32x4*)(cb + f);
        const f32x4 gg = bb + w0 * g0 + w1 * g1 + w2 * g2;
        u32x2 w; w.x = pkbf(silu_f(gg.x) * uu.x, silu_f(gg.y) * uu.y); w.y = pkbf(silu_f(gg.z) * uu.z, silu_f(gg.w) * uu.w);
        *(GAS u32x2*)(HID + (size_t)(MP + rs) * FF + f) = w;
        if (i >= 14) *(GAS f32x4*)(a->out + O_CS + (((size_t)l * DECB + sb) * 2 + (i - 14)) * FF + f) = g2;
    }
    for (int idx = gtid; idx < 256 * NF4; idx += GT) {
        const int k = idx / NF4, f = (idx - k * NF4) * 4;
        const float* sb = SBR + ((size_t)(k * 2) * 2) * FF + f;
        const f32x4 ga = *(const GAS f32x4*)(sb), ua = *(const GAS f32x4*)(sb + FF), gb = *(const GAS f32x4*)(sb + 2 * FF), ub = *(const GAS f32x4*)(sb + 3 * FF);
        const bool start = (k & 127) == 0;
        f32x4 h1 = {0.f, 0.f, 0.f, 0.f}, h0 = {0.f, 0.f, 0.f, 0.f};
        if (!start) { h1 = *(const GAS f32x4*)(GH + ((size_t)(k - 1) * 2 + 1) * FF + f); h0 = *(const GAS f32x4*)(GH + ((size_t)(k - 1) * 2) * FF + f); }
        const f32x4 w0 = *(const GAS f32x4*)(cw + f), w1 = *(const GAS f32x4*)(cw + FF + f), w2 = *(const GAS f32x4*)(cw + 2 * FF + f), bb = *(const GAS f32x4*)(cb + f);
        const f32x4 xa = bb + w0 * h0 + w1 * h1 + w2 * ga, xb = bb + w0 * h1 + w1 * ga + w2 * gb;
        u32x2 wa, wb; wa.x = pkbf(silu_f(xa.x) * ua.x, silu_f(xa.y) * ua.y); wa.y = pkbf(silu_f(xa.z) * ua.z, silu_f(xa.w) * ua.w);
        wb.x = pkbf(silu_f(xb.x) * ub.x, silu_f(xb.y) * ub.y); wb.y = pkbf(silu_f(xb.z) * ub.z, silu_f(xb.w) * ub.w);
        *(GAS u32x2*)(HID + (size_t)(64 * k) * FF + f) = wa; *(GAS u32x2*)(HID + (size_t)(64 * k + 1) * FF + f) = wb;
    }
}

#define PH_IDS() const int tid = fresh_tid(), lane = tid & 63, wave = __builtin_amdgcn_readfirstlane(tid >> 6); const int bx = fresh_bx(), G = gridDim.x; \
    const int vcu = (G % 8 == 0) ? (bx % 8) * (G / 8) + bx / 8 : bx; const int gw = vcu * NWAVES + wave, NGW = G * NWAVES, gtid = bx * NTHR + tid, GT = G * NTHR; \
    KArgs a = kargs(); unsigned char* ws = a->ws; (void)lane; (void)gw; (void)NGW; (void)gtid; (void)GT; (void)ws
#define GRID_BAR() do { KArgs a_ = kargs(); XcdBarrier b_; b_.bar = (unsigned*)(a_->ws + WS_CTL) + CW_BAR; b_.x = xb_xcc_id(); b_.st = (volatile LAS unsigned*)(lds + LCTL_OFF) + 8; xcd_barrier(b_); } while (0)
#ifdef PROBE_SEL
#define PROBE_T0() do { if (blockIdx.x == 0 && threadIdx.x == 0) { volatile LAS unsigned* LC_ = (volatile LAS unsigned*)(lds + LCTL_OFF); LC_[15] = (unsigned)__builtin_amdgcn_s_memrealtime(); } } while (0)
#define PROBE_ACC(k) do { if (blockIdx.x == 0 && threadIdx.x == 0) { volatile LAS unsigned* LC_ = (volatile LAS unsigned*)(lds + LCTL_OFF); const unsigned n_ = (unsigned)__builtin_amdgcn_s_memrealtime(); LC_[16 + (k)] += n_ - LC_[15]; LC_[15] = n_; } } while (0)
#define PROBE_IT0() do { if (blockIdx.x == 0 && threadIdx.x == 0) { volatile LAS unsigned* LC_ = (volatile LAS unsigned*)(lds + LCTL_OFF); LC_[12] = (unsigned)__builtin_amdgcn_s_memrealtime(); } } while (0)
#define PROBE_IT1(k) do { __syncthreads(); if (blockIdx.x == 0 && threadIdx.x == 0) { volatile LAS unsigned* LC_ = (volatile LAS unsigned*)(lds + LCTL_OFF); LC_[40 + (k)] += (unsigned)__builtin_amdgcn_s_memrealtime() - LC_[12]; } } while (0)
#define PROBE_KIND(k) do { if (threadIdx.x == 0) { volatile LAS unsigned* LC_ = (volatile LAS unsigned*)(lds + LCTL_OFF); LC_[14] = (k); } __syncthreads(); } while (0)
#else
#define PROBE_T0() do {} while (0)
#define PROBE_KIND(k) do {} while (0)
#define PROBE_IT0() do {} while (0)
#define PROBE_IT1(k) do {} while (0)
#define PROBE_ACC(k) do {} while (0)
#endif
__global__ void __launch_bounds__(NTHR, 2) fwd(Args a_unused) {
    extern __shared__ __attribute__((aligned(16))) unsigned char lds_raw[];
    LAS unsigned char* lds = (LAS unsigned char*)lds_raw;
    { volatile LAS unsigned* LC = (volatile LAS unsigned*)(lds + LCTL_OFF);
      if (threadIdx.x < 64) LC[threadIdx.x] = 0u;
      __syncthreads();
      KArgs a = kargs();
      (void)xcd_barrier_post((unsigned*)(a->ws + WS_CTL) + CW_BAR, LC + 8); }

    PROBE_T0();
    { PH_IDS(); asm volatile("; MARK_PHASE_1" ::: "memory"); p0_prologue(a, lds, gw, NGW, wave, lane, gtid, GT); }
    GRID_BAR(); PROBE_ACC(0);

    for (int l = 0; l < NL; ++l) {
        if (l) { { PH_IDS(); asm volatile("; MARK_PHASE_2" ::: "memory"); sample_rows_phase(a->out, (bf16*)(ws + WS_H), (float*)(ws + WS_SS1), (const float*)(ws + WS_SSP), (const float*)(ws + WS_PART), NP_DN, lds, bx, G, tid); }
                 GRID_BAR(); PROBE_ACC(1); }
        { PH_IDS(); asm volatile("; MARK_PHASE_3" ::: "memory"); pg8::Gemm g{(const bf16*)(ws + WS_H), (const bf16*)(ws + WS_W + (size_t)l * SZ_WL), MT, NIN, DM}; pg8::StaticOrder S; S.init(MT, NIN, G, bx, WGM_IN);
          pg8::EpiBf16RS E{(bf16*)(ws + WS_PROJ), NIN, (const float*)(ws + WS_SS1), 1.f / DM, EPS, a->out + O_VP + (size_t)l * MP * 1024, a->out + O_VS + (size_t)l * MS * 1024, C_SV / 256, MP, MR};
          PROBE_KIND(0); pg8::gemm_phase<pg8::EpiBf16RS, pg8::StaticOrder, true, true>(lds, g, S, E); }
        GRID_BAR(); PROBE_ACC(2);
        { PH_IDS(); asm volatile("; MARK_PHASE_4" ::: "memory"); bf16* PROJ = (bf16*)(ws + WS_PROJ);
          { const float* w2l = a->in[10] + (size_t)l * 16 * 256; const float* bl = a->in[11] + (size_t)l * 256;
            for (int it = bx; it < 1024; it += G) gla_prep_item(lds, PROJ, it, w2l, bl, (float*)(ws + WS_GLAU), (float*)(ws + WS_GLAD), ws + WS_GLAF, fresh_tid()); } }
        GRID_BAR(); PROBE_ACC(3);
        { PH_IDS(); asm volatile("; MARK_PHASE_5" ::: "memory"); bf16* PROJ = (bf16*)(ws + WS_PROJ); bf16* MIX = (bf16*)(ws + WS_MIX);
          volatile LAS unsigned* LC = (volatile LAS unsigned*)(lds + LCTL_OFF);
          unsigned* qctr = (unsigned*)(ws + WS_CTL) + CW_Q + 64 * l;
          constexpr int QS = 128, Q1 = QS + 512, Q2 = Q1 + 64, Q2b = Q2 + 544, Q3 = Q2b + 1024 + 32;
          unsigned* scnt = (unsigned*)(ws + WS_CTL) + CW_Q + 64 * (16 + l);
          if (tid == 0) LC[3] = 0u;
          unsigned nxt = 0u; if (tid == 0) nxt = __hip_atomic_fetch_add(qctr, 1u, __ATOMIC_RELAXED, __HIP_MEMORY_SCOPE_AGENT);
          for (;;) {
              __syncthreads();
              if (tid == 0) LC[0] = nxt;
              __syncthreads();
              const int it = (int)LC[0];
              if (it >= Q3) break;
              if (tid == 0) nxt = __hip_atomic_fetch_add(qctr, 1u, __ATOMIC_RELAXED, __HIP_MEMORY_SCOPE_AGENT);
              PROBE_IT0();
              if (it < QS) { asm volatile("; MARK_ITEM_SCAN" ::: "memory");
                  gla_scan_item((float*)(ws + WS_GLAU), (const float*)(ws + WS_GLAD), a->out + O_GP + (size_t)l * 8 * 8192, it * NTHR + fresh_tid());
                  asm volatile("s_waitcnt vmcnt(0)" ::: "memory"); __syncthreads();
                  if (tid == 0) { __builtin_amdgcn_fence(__ATOMIC_RELEASE, "agent"); asm volatile("s_waitcnt vmcnt(0)" ::: "memory");
                                  __hip_atomic_fetch_add(scnt, 1u, __ATOMIC_RELAXED, __HIP_MEMORY_SCOPE_AGENT); } }
              else if (it < Q1) { asm volatile("; MARK_ITEM_ATT" ::: "memory"); const int i2 = it - QS; att::attn_item((char*)lds_raw, PROJ, MIX, (i2 & 15) >> 3, i2 & 7, 31 - (i2 >> 4), fresh_tid(), a->in[13] + (size_t)l * 128, a->in[14] + (size_t)l * 128, a->out + O_KP + (size_t)l * MP * 1024); }
              else if (it < Q2) { asm volatile("; MARK_ITEM_SATT" ::: "memory"); sattn_item((LAS float*)lds, PROJ, MIX, it - Q1, l, a, fresh_tid()); }
              else if (it < Q2b) { asm volatile("; MARK_ITEM_CM" ::: "memory"); cm_item(lds, PROJ, MIX, it - Q2, l, a, fresh_tid()); }
              else { asm volatile("; MARK_ITEM_GLA" ::: "memory");
                  if (LC[3] == 0u) {
                      if (tid == 0) { unsigned sp = 0u; while (__hip_atomic_load(scnt, __ATOMIC_RELAXED, __HIP_MEMORY_SCOPE_AGENT) < (unsigned)QS) { __builtin_amdgcn_s_sleep(2); if (++sp > (1u << 22)) break; }
                                      __builtin_amdgcn_fence(__ATOMIC_ACQUIRE, "agent"); asm volatile("s_waitcnt vmcnt(0)" ::: "memory"); }
                      __syncthreads();
                      if (tid == 0) LC[3] = 1u; }
                  const int gi = it - Q2b;
                  if (gi < 32) gla_mix_item(lds, PROJ, MIX, NGLA_P + gi, l, a, (const float*)(ws + WS_GLAU), (const float*)(ws + WS_GLAD), fresh_tid());
                  else gla_chunk_item(lds, PROJ, MIX, gi - 32, l, a, (const float*)(ws + WS_GLAU), ws + WS_GLAF, fresh_tid()); }
              PROBE_IT1(it < QS ? 4 : it < Q1 ? 1 : it < Q2 ? 2 : it < Q2b ? 3 : 0);
          } }
        GRID_BAR(); PROBE_ACC(4);
        { PH_IDS(); asm volatile("; MARK_PHASE_6" ::: "memory"); pg8::Gemm g{(const bf16*)(ws + WS_MIX), (const bf16*)(ws + WS_W + (size_t)l * SZ_WL + SZ_WIN), MT, DM, DM}; pg8::SplitOrder S; S.init(MP, DM, DM, G, bx, 4, WGM_OUT);
          pg8::EpiResF32 E{nullptr, DM, MR, (float*)(ws + WS_PART), (bf16*)(ws + WS_H), (float*)(ws + WS_SSP)};
          PROBE_KIND(1); pg8::gemm_phase<pg8::EpiResF32, pg8::SplitOrder, true, true>(lds, g, S, E); }
        GRID_BAR(); PROBE_ACC(5);
        { PH_IDS(); asm volatile("; MARK_PHASE_7" ::: "memory"); sample_rows_phase(a->out, (bf16*)(ws + WS_H), (float*)(ws + WS_SS2), (const float*)(ws + WS_SSP), (const float*)(ws + WS_PART), NP_OUT, lds, bx, G, tid); }
        GRID_BAR(); PROBE_ACC(6);
        { PH_IDS(); asm volatile("; MARK_PHASE_8" ::: "memory"); pg8::Gemm g{(const bf16*)(ws + WS_H), (const bf16*)(ws + WS_W + (size_t)l * SZ_WL + SZ_WIN + SZ_WOUT), MT, NGU, DM}; pg8::SplitOrder S; S.init(MP, NGU, DM, G, bx, GU_PNT, WGM_GU);
          pg8::EpiConv E{(bf16*)(ws + WS_HID), a->in[19] + (size_t)l * 3 * FF, a->in[20] + (size_t)l * FF, (float*)(ws + WS_GH), (float*)(ws + WS_SBR),
                         a->out + O_CP + (size_t)l * NBATCH * 2 * FF, a->out + O_CS + (size_t)l * DECB * 2 * FF, a->in[5] + (size_t)l * DECB * 2 * FF, FF, MP, MR, SEQ, (const float*)(ws + WS_SS2), 1.f / DM, EPS, (float*)(ws + WS_PGU), GU_PNT};
          PROBE_KIND(2); pg8::gemm_phase<pg8::EpiConv, pg8::SplitOrder, true, true>(lds, g, S, E); }
        GRID_BAR(); PROBE_ACC(7);
        { PH_IDS(); asm volatile("; MARK_PHASE_9" ::: "memory"); conv_fix_phase((const float*)(ws + WS_GH), (const float*)(ws + WS_SBR), (bf16*)(ws + WS_HID), (const float*)(ws + WS_PGU), (const float*)(ws + WS_SS2), l, a, gtid, GT); }
        GRID_BAR(); PROBE_ACC(8);
        { PH_IDS(); asm volatile("; MARK_PHASE_10" ::: "memory"); pg8::Gemm g{(const bf16*)(ws + WS_HID), (const bf16*)(ws + WS_W + (size_t)l * SZ_WL + SZ_WIN + SZ_WOUT + SZ_WGU), MT, DM, FF}; pg8::SplitOrder S; S.init(MP, DM, FF, G, bx, 4, WGM_DN);
          pg8::EpiResF32 E{l == NL - 1 ? a->out : nullptr, DM, MR, (float*)(ws + WS_PART), (bf16*)(ws + WS_H), (float*)(ws + WS_SSP)};
          PROBE_KIND(3); pg8::gemm_phase<pg8::EpiResF32, pg8::SplitOrder, true, true>(lds, g, S, E); }
        GRID_BAR(); PROBE_ACC(9);
    }
    { PH_IDS(); sample_rows_phase(a->out, nullptr, nullptr, nullptr, (const float*)(ws + WS_PART), NP_DN, lds, bx, G, tid); }
#ifdef PROBE_SEL
    if (blockIdx.x == 0 && threadIdx.x == 0) { volatile LAS unsigned* LC_ = (volatile LAS unsigned*)(lds + LCTL_OFF); unsigned tot = 0;
        for (int k = 0; k < 10; ++k) if ((PROBE_SEL >> k) & 1) tot += LC_[16 + k];
        for (int k = 0; k < 12; ++k) if ((PROBE_SEL >> (16 + k)) & 1) tot += LC_[32 + k];
        const unsigned t0 = (unsigned)__builtin_amdgcn_s_memrealtime(); while ((unsigned)__builtin_amdgcn_s_memrealtime() - t0 < tot) __builtin_amdgcn_s_sleep(8); }
#endif
}

extern "C" void kernel_launch(void* const* d_in, const int* in_sizes, int n_in, void* d_out, int out_size, void* d_ws, size_t ws_size, hipStream_t stream) {
    static int grid = 0;
    if (grid == 0) {
        if (n_in != 22 || (size_t)out_size != O_END || ws_size < WS_END) { fprintf(stderr, "kernel_launch: unexpected shapes (n_in %d, out %d want %zu, ws %zu want >= %zu); nothing launched\n", n_in, out_size, (size_t)O_END, ws_size, (size_t)WS_END); grid = -1; return; }
        int dev = 0, cus = 0, per_cu = 0;
        if (hipGetDevice(&dev) != hipSuccess || hipDeviceGetAttribute(&cus, hipDeviceAttributeMultiprocessorCount, dev) != hipSuccess) { grid = -1; return; }
        if (hipFuncSetAttribute((const void*)fwd, hipFuncAttributeMaxDynamicSharedMemorySize, LDS_BYTES) != hipSuccess) { fprintf(stderr, "kernel_launch: hipFuncSetAttribute failed\n"); grid = -1; return; }
        if (hipOccupancyMaxActiveBlocksPerMultiprocessor(&per_cu, (const void*)fwd, NTHR, LDS_BYTES) != hipSuccess || per_cu < 1) { fprintf(stderr, "kernel_launch: occupancy query reports %d blocks per CU\n", per_cu); }
        (void)hipGetLastError();
        grid = cus;
    }
    if (grid < 0) return;
    (void)hipMemsetAsync((char*)d_ws + WS_CTL, 0, CTL_ZERO_BYTES, stream);
    Args a{};
    for (int i = 0; i < 22; ++i) a.in[i] = (const float*)d_in[i];
    a.out = (float*)d_out; a.ws = (unsigned char*)d_ws;
    hipLaunchKernelGGL(fwd, dim3(grid), dim3(NTHR), LDS_BYTES, stream, a);
}
```

```cpp
#include <hip/hip_runtime.h>
#include <cstdio>
#include <cstdint>
namespace pg8 {
#define PG8_LAS __attribute__((address_space(3)))
typedef unsigned short bf16_t;
typedef short bf16x8 __attribute__((ext_vector_type(8)));
typedef float f32x4 __attribute__((ext_vector_type(4)));
typedef unsigned u32x4 __attribute__((ext_vector_type(4)));
constexpr int BM = 256, BK = 64, HALF = 128, HTB = HALF * BK * 2  , STAGE_BYTES = 8 * HTB, NXCD = 8, WGM = 4;

__host__ __device__ __forceinline__ int lds_byte(int r, int c) { const int st = (r >> 4) * 2 + (c >> 5), rr = r & 15, cc = c & 31, ob = rr * 64 + cc * 2; return st * 1024 + (ob ^ (((ob >> 9) & 1) << 5)); }
__host__ __device__ __forceinline__ void stage_rc(int b, int& R, int& C) { const int st = b / 1024, sb = b % 1024, swz = sb ^ (((sb >> 9) & 1) << 5); R = (st >> 1) * 16 + swz / 64; C = (st & 1) * 32 + (swz % 64) / 2; }
__host__ __device__ __forceinline__ int perm32(int rho) { const int n = rho >> 4, i = rho & 15; return 8 * (i >> 2) + 4 * n + (i & 3); }

struct Unit { int pm, pn, kt0, nt, par; };
struct Gemm { const bf16_t* A; const bf16_t* Bt; int M, N, K; };

struct StaticOrder {
    int nM, nN, nwg, G, c, wgm;
    __host__ __device__ void init(int M, int N, int G_, int c_, int wgm_ = WGM) { nM = M / BM; nN = N / BM; nwg = nM * nN; G = G_; c = c_; wgm = wgm_; }
    __host__ __device__ bool next(int i, Unit& u) const {
        const long L = (long)i * G + c; if (L >= nwg) return false;
        int wgid = (int)L; { const int q = nwg / NXCD, r = nwg % NXCD, xcd = wgid % NXCD, off = wgid / NXCD; wgid = (xcd < r ? xcd * (q + 1) : r * (q + 1) + (xcd - r) * q) + off; }
        const int nig = wgm * nN, gid = wgid / nig, fm = gid * wgm, gsz = (nM - fm) < wgm ? (nM - fm) : wgm;
        u.pm = fm + ((wgid % nig) % gsz); u.pn = (wgid % nig) / gsz; u.kt0 = 0; u.nt = 0; return true;
    }
    __device__ __forceinline__ void a_ready(const Unit&) const {}
    __device__ __forceinline__ void done(const Unit&) const {}
};
struct SplitOrder {
    StaticOrder base; int nmain, npieces, nN, pm_s, pnt;
    __host__ __device__ void init(int Mmain, int N, int K, int G_, int c_, int pnt_ = 4, int wgm_ = WGM) { base.init(Mmain, N, G_, c_, wgm_); nmain = base.nwg; nN = N / BM; pnt = pnt_; npieces = nN * (K / (pnt_ * BK)); pm_s = Mmain / BM; }
    __host__ __device__ bool next(int i, Unit& u) const {
        const long L = (long)i * base.G + base.c; if (L < nmain) return base.next(i, u);
        const int p = (int)(L - nmain); if (p >= npieces) return false;
        u.pm = pm_s; u.pn = p % nN; u.kt0 = (p / nN) * pnt; u.nt = pnt; return true;
    }
    __device__ __forceinline__ void a_ready(const Unit&) const {}
    __device__ __forceinline__ void done(const Unit&) const {}
};


__device__ __forceinline__ unsigned cvt_pk_bf16(float lo, float hi) { unsigned r; asm volatile("v_cvt_pk_bf16_f32 %0, %1, %2" : "=v"(r) : "v"(lo), "v"(hi)); return r; }
typedef float f32x2 __attribute__((ext_vector_type(2)));
__device__ __forceinline__ f32x2 gelu_pk(f32x2 v) {
    const f32x2 av = __builtin_elementwise_abs(v), d = av * 0.2316418882f + 1.0f;
    f32x2 t; t.x = __builtin_amdgcn_rcpf(d.x); t.y = __builtin_amdgcn_rcpf(d.y);
    f32x2 q = t * 0.5307027145f + (-0.7265760135f); q = q * t + 0.7107068705f; q = q * t + (-0.142248368f); q = q * t + 0.127414796f; q = q * t;
    const f32x2 s = (v * v) * (-0.72134752044f);
    f32x2 e; e.x = __builtin_amdgcn_exp2f(s.x); e.y = __builtin_amdgcn_exp2f(s.y);
    const f32x2 m = v * (q * e), r = v - m;
    f32x2 o; o.x = v.x < 0.f ? m.x : r.x; o.y = v.y < 0.f ? m.y : r.y; return o;
}

template <int ACT  > struct EpiBf16 {
    static constexpr bool PERM = true, AFTER_DRAIN = false; static_assert(ACT == 0 || ACT == 1, "EpiBf16: ACT is 0 (none) or 1 (gelu_pk)");
    bf16_t* O; int ldc; const float* bias; int split_cols; size_t split_stride; float scale0;
    __device__ __forceinline__ void operator()(const f32x4 (&acc)[2][2][4][2], const Unit& u, int wr, int wc, int fr, int fq) const {
        const int row0 = u.pm * BM + wr * 64 + fr; int colt = u.pn * BM; bf16_t* base = O;
        float sc = 1.f; if (split_cols) { const int t = colt / split_cols; base += (size_t)t * split_stride; colt -= t * split_cols; if (t == 0) sc = scale0; }
        const int col0 = colt + wc * 32 + 8 * fq, bcol0 = u.pn * BM + wc * 32 + 8 * fq;
        f32x4 bv[2][2];
#pragma unroll
        for (int bj = 0; bj < 2; ++bj)
#pragma unroll
            for (int n = 0; n < 2; ++n) bv[bj][n] = bias ? *(const f32x4*)(bias + bcol0 + bj * HALF + 4 * n) : (f32x4){0.f, 0.f, 0.f, 0.f};
#pragma unroll
        for (int ai = 0; ai < 2; ++ai)
#pragma unroll
            for (int m = 0; m < 4; ++m) { bf16_t* rowp = base + (size_t)(row0 + ai * HALF + m * 16) * ldc + col0;
#pragma unroll
                for (int bj = 0; bj < 2; ++bj) { f32x4 v0 = acc[ai][bj][m][0] + bv[bj][0], v1 = acc[ai][bj][m][1] + bv[bj][1];
                    if (ACT == 1) { f32x2 a = gelu_pk((f32x2){v0[0], v0[1]}), b = gelu_pk((f32x2){v0[2], v0[3]}), c = gelu_pk((f32x2){v1[0], v1[1]}), d = gelu_pk((f32x2){v1[2], v1[3]});
                        v0 = (f32x4){a.x, a.y, b.x, b.y}; v1 = (f32x4){c.x, c.y, d.x, d.y}; }
                    v0 = v0 * sc; v1 = v1 * sc; u32x4 w; w.x = cvt_pk_bf16(v0[0], v0[1]); w.y = cvt_pk_bf16(v0[2], v0[3]); w.z = cvt_pk_bf16(v1[0], v1[1]); w.w = cvt_pk_bf16(v1[2], v1[3]);
                    *(u32x4*)(rowp + bj * HALF) = w; } }
    }
};

typedef unsigned u32x2 __attribute__((ext_vector_type(2)));

template <int M> __device__ __forceinline__ float shx_(float v) { return __int_as_float(__builtin_amdgcn_ds_swizzle(__float_as_int(v), 0x1f | (M << 10))); }
__device__ __forceinline__ float sum_x32_(float v) { auto rr = __builtin_amdgcn_permlane32_swap(__float_as_uint(v), __float_as_uint(v), false, false); return __uint_as_float(rr[0]) + __uint_as_float(rr[1]); }
struct EpiBf16RS {
    static constexpr bool PERM = true, AFTER_DRAIN = false; static constexpr int SMIN = 16;
    bf16_t* O; int ldc; const float* SS; float inv_k, eps; float* vout_p; float* vout_s; int pn_v, mp, mr;
    static constexpr int XL_SS = 140288;
    __device__ __forceinline__ void stage(const Unit& u, PG8_LAS unsigned char* lds, int wid, int lane) const {
        if (wid == 0) __builtin_amdgcn_global_load_lds((const unsigned*)(SS + (size_t)u.pm * BM + lane * 4), (PG8_LAS unsigned*)(lds + XL_SS + u.par * 1024), 16, 0, 0);
    }
    __device__ __forceinline__ void operator()(const f32x4 (&acc)[2][2][4][2], const Unit& u, int wr, int wc, int fr, int fq, PG8_LAS unsigned char* lds) const {
        const int row0 = u.pm * BM + wr * 64 + fr, col0 = u.pn * BM + wc * 32 + 8 * fq; const bool vt = u.pn >= pn_v && u.pn < pn_v + 4; const int vc0 = (u.pn - pn_v) * BM + wc * 32 + 8 * fq;
#pragma unroll
        for (int ai = 0; ai < 2; ++ai)
#pragma unroll
            for (int m = 0; m < 4; ++m) { const int row = row0 + ai * HALF + m * 16; const float rs = rsqrtf(*(const PG8_LAS float*)(lds + XL_SS + u.par * 1024 + (ai * HALF + wr * 64 + m * 16 + fr) * 4) * inv_k + eps); bf16_t* rowp = O + (size_t)row * ldc + col0;
#pragma unroll
                for (int bj = 0; bj < 2; ++bj) { const f32x4 v0 = acc[ai][bj][m][0] * rs, v1 = acc[ai][bj][m][1] * rs;
                    u32x4 w; w.x = cvt_pk_bf16(v0[0], v0[1]); w.y = cvt_pk_bf16(v0[2], v0[3]); w.z = cvt_pk_bf16(v1[0], v1[1]); w.w = cvt_pk_bf16(v1[2], v1[3]);
                    *(u32x4*)(rowp + bj * HALF) = w;
                    if (vt && row < mr) { float* vp = (row < mp ? vout_p + (size_t)row * 1024 : vout_s + (size_t)(row - mp) * 1024) + vc0 + bj * HALF; __builtin_nontemporal_store(v0, (f32x4*)vp); __builtin_nontemporal_store(v1, (f32x4*)(vp + 4)); } } }
    }
};
struct EpiResF32 {
    static constexpr bool PERM = false, AFTER_DRAIN = false; static constexpr int SMIN = 16;
    float* Y; int ldc; int mreal; float* PART; bf16_t* XB; float* SS;
    __device__ __forceinline__ void stage(const Unit&, PG8_LAS unsigned char*, int, int) const {}
    __device__ __forceinline__ void operator()(const f32x4 (&acc)[2][2][4][2], const Unit& u, int wr, int wc, int fr, int fq, PG8_LAS unsigned char*) const {
        const int col0 = u.pn * BM + wc * 32 + 4 * fq;
        if (u.nt) {
            float* P = PART + (size_t)(u.kt0 >> 2) * 128 * ldc;
#pragma unroll
            for (int m = 0; m < 4; ++m) { float* rowp = P + (size_t)(wr * 64 + m * 16 + fr) * ldc + col0;
#pragma unroll
                for (int bj = 0; bj < 2; ++bj)
#pragma unroll
                    for (int n = 0; n < 2; ++n) *(f32x4*)(rowp + bj * HALF + n * 16) = acc[0][bj][m][n]; }
            return;
        }
        const int row0 = u.pm * BM + wr * 64 + fr;
        u32x2 cur[4], nxt[4];
        { const bf16_t* rp = XB + (size_t)row0 * ldc + col0;
#pragma unroll
          for (int q = 0; q < 4; ++q) cur[q] = *(const u32x2*)(rp + (q >> 1) * HALF + (q & 1) * 16); }
#pragma unroll
        for (int g = 0; g < 8; ++g) { const int ai = g >> 2, m = g & 3; const int row = row0 + ai * HALF + m * 16;
            if (g < 7) { const int r2 = row0 + ((g + 1) >> 2) * HALF + ((g + 1) & 3) * 16; const bf16_t* rp = XB + (size_t)r2 * ldc + col0;
#pragma unroll
                for (int q = 0; q < 4; ++q) nxt[q] = *(const u32x2*)(rp + (q >> 1) * HALF + (q & 1) * 16); }
            bf16_t* xbp = XB + (size_t)row * ldc + col0; float ss = 0.f;
#pragma unroll
            for (int q = 0; q < 4; ++q) { const int bj = q >> 1, n = q & 1;
                const f32x4 x = {__uint_as_float(cur[q].x << 16), __uint_as_float(cur[q].x & 0xffff0000u), __uint_as_float(cur[q].y << 16), __uint_as_float(cur[q].y & 0xffff0000u)};
                const f32x4 v = x + acc[ai][bj][m][n];
                if (Y) __builtin_nontemporal_store(v, (f32x4*)(Y + (size_t)row * ldc + col0 + bj * HALF + n * 16));
                else { u32x2 w; w.x = cvt_pk_bf16(v[0], v[1]); w.y = cvt_pk_bf16(v[2], v[3]); *(u32x2*)(xbp + bj * HALF + n * 16) = w; }
                ss += (v[0] * v[0] + v[1] * v[1]) + (v[2] * v[2] + v[3] * v[3]); }
            ss += shx_<16>(ss); ss = sum_x32_(ss);
            if (fq == 0) SS[(size_t)row * 32 + u.pn * 4 + wc] = ss;
#pragma unroll
            for (int q = 0; q < 4; ++q) cur[q] = nxt[q];
        }
    }
};

template <int CTRL> __device__ __forceinline__ float dppf(float old, float src) { return __int_as_float(__builtin_amdgcn_update_dpp(__float_as_int(old), __float_as_int(src), CTRL, 0xf, 0xf, false)); }
struct EpiConv {
    static constexpr bool PERM = true, AFTER_DRAIN = false; static constexpr int SMIN = 16;
    bf16_t* HID; const float* cw; const float* cb; float* GH; float* SBR; float* out_cp; float* out_cs; const float* st_in; int ff, mp, mr, seq; const float* SS; float inv_k, eps; float* PGU; int pnt;
    static constexpr int XL_SS = 140288, XL_CW = 142336;
    __device__ __forceinline__ void stage(const Unit& u, PG8_LAS unsigned char* lds, int wid, int lane) const {
        if (wid == 0 && u.nt == 0) {
            __builtin_amdgcn_global_load_lds((const unsigned*)(SS + (size_t)u.pm * BM + lane * 4), (PG8_LAS unsigned*)(lds + XL_SS + u.par * 1024), 16, 0, 0);
            const int f = u.pn * 128 + (lane & 31) * 4, hs = lane >> 5;
            __builtin_amdgcn_global_load_lds((const unsigned*)(cw + (size_t)hs * ff + f), (PG8_LAS unsigned*)(lds + XL_CW + u.par * 2048), 16, 0, 0);
            __builtin_amdgcn_global_load_lds((const unsigned*)((hs ? cb : cw + 2 * (size_t)ff) + f), (PG8_LAS unsigned*)(lds + XL_CW + u.par * 2048 + 1024), 16, 0, 0);
        }
    }
    __device__ __forceinline__ void operator()(const f32x4 (&acc)[2][2][4][2], const Unit& u, int wr, int wc, int fr, int fq, PG8_LAS unsigned char* lds) const {
        if (u.nt) {
            float* P = PGU + (size_t)(u.kt0 / pnt) * 128 * (2 * ff) + u.pn * BM + wc * 32 + 8 * fq;
#pragma unroll
            for (int m = 0; m < 4; ++m) { float* rowp = P + (size_t)(wr * 64 + m * 16 + fr) * (2 * ff);
#pragma unroll
                for (int bj = 0; bj < 2; ++bj) { *(f32x4*)(rowp + bj * HALF) = acc[0][bj][m][0]; *(f32x4*)(rowp + bj * HALF + 4) = acc[0][bj][m][1]; } }
            return;
        }
        const int f0 = u.pn * 128 + wc * 32 + 8 * fq;
        float w0[8], w1[8], w2[8], bb[8];
        { const PG8_LAS f32x4* p = (const PG8_LAS f32x4*)(lds + XL_CW + u.par * 2048 + (wc * 32 + 8 * fq) * 4);
          const f32x4 a0 = p[0], a1 = p[1], b0 = p[32], b1 = p[33], c0 = p[64], c1 = p[65], d0 = p[96], d1 = p[97];
          w0[0] = a0.x; w0[1] = a0.y; w0[2] = a0.z; w0[3] = a0.w; w0[4] = a1.x; w0[5] = a1.y; w0[6] = a1.z; w0[7] = a1.w;
          w1[0] = b0.x; w1[1] = b0.y; w1[2] = b0.z; w1[3] = b0.w; w1[4] = b1.x; w1[5] = b1.y; w1[6] = b1.z; w1[7] = b1.w;
          w2[0] = c0.x; w2[1] = c0.y; w2[2] = c0.z; w2[3] = c0.w; w2[4] = c1.x; w2[5] = c1.y; w2[6] = c1.z; w2[7] = c1.w;
          bb[0] = d0.x; bb[1] = d0.y; bb[2] = d0.z; bb[3] = d0.w; bb[4] = d1.x; bb[5] = d1.y; bb[6] = d1.z; bb[7] = d1.w; }
#pragma unroll
        for (int ai = 0; ai < 2; ++ai) {
            const int rb = u.pm * BM + ai * HALF + wr * 64, blk = rb >> 6;
            float gp[8];
#pragma unroll
            for (int i = 0; i < 8; ++i) gp[i] = 0.f;
#pragma unroll
            for (int m = 0; m < 4; ++m) {
                const int row = rb + 16 * m + fr; const float rs = rsqrtf(*(const PG8_LAS float*)(lds + XL_SS + u.par * 1024 + (ai * HALF + wr * 64 + 16 * m + fr) * 4) * inv_k + eps);
                float g2[8], g1[8], g0[8], uu[8];
#pragma unroll
                for (int n = 0; n < 2; ++n)
#pragma unroll
                    for (int j = 0; j < 4; ++j) { const int i = 4 * n + j; g2[i] = acc[ai][0][m][n][j] * rs; uu[i] = acc[ai][1][m][n][j] * rs;
                        float o1 = 0.f, o2 = 0.f;
                        if (m > 0) { o1 = dppf<0x121>(0.f, gp[i]); o2 = dppf<0x122>(0.f, gp[i]); }
                        g1[i] = dppf<0x111>(o1, g2[i]); g0[i] = dppf<0x112>(o2, g2[i]); }
#pragma unroll
                for (int i = 0; i < 8; ++i) gp[i] = g2[i];
                if (row >= mp && fr < 2) {
                    int sb = (row - mp) >> 4; if (sb > 7) sb = 7; const float* st = st_in + (size_t)sb * 2 * ff + f0;
                    const f32x4 s1a = *(const f32x4*)(st + ff), s1b = *(const f32x4*)(st + ff + 4); const float s1[8] = {s1a.x, s1a.y, s1a.z, s1a.w, s1b.x, s1b.y, s1b.z, s1b.w};
                    if (fr == 0) { const f32x4 s0a = *(const f32x4*)(st), s0b = *(const f32x4*)(st + 4); const float s0[8] = {s0a.x, s0a.y, s0a.z, s0a.w, s0b.x, s0b.y, s0b.z, s0b.w};
#pragma unroll
                        for (int i = 0; i < 8; ++i) { g1[i] = s1[i]; g0[i] = s0[i]; } }
                    else {
#pragma unroll
                        for (int i = 0; i < 8; ++i) g0[i] = s1[i]; }
                }
                const bool bnd = (m == 0) && (fr < 2) && (row < mp);
                if (bnd) { float* sp = SBR + ((size_t)(blk * 2 + fr) * 2) * ff + f0;
                    *(f32x4*)(sp) = (f32x4){g2[0], g2[1], g2[2], g2[3]}; *(f32x4*)(sp + 4) = (f32x4){g2[4], g2[5], g2[6], g2[7]};
                    *(f32x4*)(sp + ff) = (f32x4){uu[0], uu[1], uu[2], uu[3]}; *(f32x4*)(sp + ff + 4) = (f32x4){uu[4], uu[5], uu[6], uu[7]}; }
                else { float hv[8];
#pragma unroll
                    for (int i = 0; i < 8; ++i) { const float g = bb[i] + w0[i] * g0[i] + w1[i] * g1[i] + w2[i] * g2[i]; hv[i] = g * __builtin_amdgcn_rcpf(1.f + __expf(-g)) * uu[i]; }
                    u32x4 w; w.x = cvt_pk_bf16(hv[0], hv[1]); w.y = cvt_pk_bf16(hv[2], hv[3]); w.z = cvt_pk_bf16(hv[4], hv[5]); w.w = cvt_pk_bf16(hv[6], hv[7]);
                    *(u32x4*)(HID + (size_t)row * ff + f0) = w; }
                if (m == 3 && fr >= 14) { float* gp = GH + ((size_t)blk * 2 + (fr - 14)) * ff + f0;
                    *(f32x4*)(gp) = (f32x4){g2[0], g2[1], g2[2], g2[3]}; *(f32x4*)(gp + 4) = (f32x4){g2[4], g2[5], g2[6], g2[7]};
                    if (row < mp && (row & (seq - 1)) >= seq - 2) { float* cp = out_cp + ((size_t)(row / seq) * 2 + (fr - 14)) * ff + f0;
                        *(f32x4*)(cp) = (f32x4){g2[0], g2[1], g2[2], g2[3]}; *(f32x4*)(cp + 4) = (f32x4){g2[4], g2[5], g2[6], g2[7]}; } }
                if (row >= mp && row < mr && fr >= 14) { float* cp = out_cs + ((size_t)((row - mp) >> 4) * 2 + (fr - 14)) * ff + f0;
                    *(f32x4*)(cp) = (f32x4){g2[0], g2[1], g2[2], g2[3]}; *(f32x4*)(cp + 4) = (f32x4){g2[4], g2[5], g2[6], g2[7]}; }
            }
        }
    }
};
#ifdef PROBE_SEL
#define PG8_PROBE_T() do { if (blockIdx.x == PROBE_BLK && wid == 0) { volatile PG8_LAS unsigned* LC_ = (volatile PG8_LAS unsigned*)(lds + 139264); LC_[13] = (unsigned)__builtin_amdgcn_s_memrealtime(); } } while (0)
#define PG8_PROBE_A(k) do { if (blockIdx.x == PROBE_BLK && wid == 0) { volatile PG8_LAS unsigned* LC_ = (volatile PG8_LAS unsigned*)(lds + 139264); const unsigned n_ = (unsigned)__builtin_amdgcn_s_memrealtime(); if (lane == 0) LC_[32 + 2 * LC_[14] + (k)] += n_ - LC_[13]; LC_[13] = n_; } } while (0)
#else
#define PG8_PROBE_T() do {} while (0)
#define PG8_PROBE_A(k) do {} while (0)
#endif
template <class Epi, class Sched, bool ALIGN_EPI = false, bool SP2 = false>
__device__ __forceinline__ void gemm_phase(PG8_LAS unsigned char* lds, const Gemm g, const Sched& S, const Epi& E) {
    int tid_l = threadIdx.x; asm volatile("" : "+v"(tid_l)); const int tid = tid_l, wid = __builtin_amdgcn_readfirstlane(tid >> 6), lane = tid & 63, wr = wid >> 2, wc = wid & 3, fr = lane & 15, fq = lane >> 4;
    const int K = g.K, nt = K / BK;
    unsigned voffA[2], voffB[2];
#pragma unroll
    for (int i = 0; i < 2; ++i) { int R, C; stage_rc(tid * 16 + i * 8192, R, C); const int Rb = Epi::PERM ? ((R & ~31) + perm32(R & 31)) : R;
        voffA[i] = (unsigned)(R * K + C) * 2u; voffB[i] = (unsigned)(Rb * K + C) * 2u; }
    const size_t kstep = (size_t)(BK * 2);
    const size_t hstep = (size_t)HALF * K * 2;
    const size_t tstep = 2 * hstep;
    const unsigned ldsw = (unsigned)wid * 1024u;
    const int aoff = lds_byte(wr * 64 + fr, fq * 8), boff = lds_byte(wc * 32 + fr, fq * 8);
#define PG8_SA(b, h) (((b) * 2 + (h)) * HTB)
#define PG8_SB(b, h) ((4 + (b) * 2 + (h)) * HTB)
#define PG8_STAGE(bufoff, gbase, voff) do { _Pragma("unroll") for (int _i = 0; _i < 2; ++_i) \
        __builtin_amdgcn_global_load_lds((const unsigned*)((const char*)(gbase) + (voff)[_i]), (PG8_LAS unsigned*)(lds + (bufoff) + ldsw + _i * 8192), 16, 0, 0); } while (0)
#define PG8_LDA(dst, b, h) do { _Pragma("unroll") for (int m = 0; m < 4; ++m) _Pragma("unroll") for (int k = 0; k < 2; ++k) dst[m][k] = *(const PG8_LAS bf16x8*)(lds + PG8_SA(b, h) + aoff + m * 2048 + k * 1024); } while (0)
#define PG8_LDB(dst, b, h) do { _Pragma("unroll") for (int n = 0; n < 2; ++n) _Pragma("unroll") for (int k = 0; k < 2; ++k) dst[n][k] = *(const PG8_LAS bf16x8*)(lds + PG8_SB(b, h) + boff + n * 2048 + k * 1024); } while (0)
#define PG8_MMA(ai, bj, At, Bt) do { __builtin_amdgcn_s_setprio(1); _Pragma("unroll") for (int m = 0; m < 4; ++m) _Pragma("unroll") for (int n = 0; n < 2; ++n) _Pragma("unroll") for (int k = 0; k < 2; ++k) \
        acc[ai][bj][m][n] = __builtin_amdgcn_mfma_f32_16x16x32_bf16(Bt[n][k], At[m][k], acc[ai][bj][m][n], 0, 0, 0); __builtin_amdgcn_s_setprio(0); } while (0)
#define PG8_WAIT_V(n) asm volatile("s_waitcnt vmcnt(" #n ")" ::: "memory")
#define PG8_XSPARE 147456
#define PG8_LDA_OFF(dst, off) do { _Pragma("unroll") for (int m = 0; m < 4; ++m) _Pragma("unroll") for (int k = 0; k < 2; ++k) dst[m][k] = *(const PG8_LAS bf16x8*)(lds + (off) + m * 2048 + k * 1024); } while (0)
#define PG8_WAIT_VS() asm volatile("s_waitcnt vmcnt(%0)" :: "i"(8 + Epi::SMIN) : "memory")
#define PG8_WAIT_L(n) asm volatile("s_waitcnt lgkmcnt(" #n ")" ::: "memory")
#define PG8_BAR __builtin_amdgcn_s_barrier()
#define PG8_SCHED __builtin_amdgcn_sched_barrier(0)
    Unit cur, nxt; int ui = 0;
    if (!S.next(0, cur)) return;
    f32x4 acc[2][2][4][2];
#pragma unroll
    for (int a = 0; a < 2; ++a)
#pragma unroll
        for (int b = 0; b < 2; ++b)
#pragma unroll
            for (int m = 0; m < 4; ++m)
#pragma unroll
                for (int n = 0; n < 2; ++n) acc[a][b][m][n] = (f32x4){0.f, 0.f, 0.f, 0.f};
    bf16x8 At[4][2], B0[2][2], B1[2][2];
    const char* cA = (const char*)g.A + (size_t)cur.pm * tstep + (size_t)cur.kt0 * kstep; const char* cB = (const char*)g.Bt + (size_t)cur.pn * tstep + (size_t)cur.kt0 * kstep;
    S.a_ready(cur);
    cur.par = 0; E.stage(cur, lds, wid, lane);
    if constexpr (SP2) {
        PG8_STAGE(PG8_SB(0, 0), cB, voffB); PG8_STAGE(PG8_SB(0, 1), cB + hstep, voffB); PG8_STAGE(PG8_SA(0, 0), cA, voffA); PG8_STAGE(PG8_SA(0, 1), cA + hstep, voffA);
        if (wr == 1) PG8_BAR;
        PG8_WAIT_V(2); PG8_BAR;
        PG8_STAGE(PG8_SB(1, 0), cB + kstep, voffB); PG8_STAGE(PG8_SA(1, 0), cA + kstep, voffA); PG8_STAGE(PG8_SB(1, 1), cB + hstep + kstep, voffB);
        PG8_WAIT_V(6); PG8_BAR;
    } else {
        PG8_STAGE(PG8_SB(0, 0), cB, voffB); PG8_STAGE(PG8_SA(0, 0), cA, voffA); PG8_STAGE(PG8_SB(0, 1), cB + hstep, voffB); PG8_STAGE(PG8_SA(0, 1), cA + hstep, voffA);
        if (wr == 1) PG8_BAR;
        PG8_WAIT_V(4); PG8_BAR;
        PG8_STAGE(PG8_SB(1, 0), cB + kstep, voffB); PG8_STAGE(PG8_SA(1, 0), cA + kstep, voffA); PG8_STAGE(PG8_SB(1, 1), cB + hstep + kstep, voffB);
        PG8_WAIT_V(6); PG8_BAR;
    }
    for (;;) {
        const bool has_next = S.next(ui + 1, nxt);
        const char* nA = has_next ? (const char*)g.A + (size_t)nxt.pm * tstep + (size_t)nxt.kt0 * kstep : cA; const char* nB = has_next ? (const char*)g.Bt + (size_t)nxt.pn * tstep + (size_t)nxt.kt0 * kstep : cB;
        const int cnt = cur.nt ? cur.nt : nt;
        PG8_PROBE_T();
        int seamf = __builtin_amdgcn_readfirstlane((SP2 && ui > 0) ? 1 : 0); asm volatile("" : "+s"(seamf));
        for (int t = 0; t < cnt; t += 2) {
            const bool last = (t == cnt - 2);
            const char* a1 = cA + (size_t)(t + 1) * kstep;
            const char* a2 = last ? nA : cA + (size_t)(t + 2) * kstep; const char* b2 = last ? nB : cB + (size_t)(t + 2) * kstep;
            const char* a3 = a2 + kstep; const char* b3 = b2 + kstep;
            if (last && has_next) S.a_ready(nxt);
            if constexpr (SP2) {
            const bool seam = seamf != 0; seamf = 0; asm volatile("" : "+s"(seamf));
            PG8_LDB(B0, 0, 0); PG8_LDB(B1, 0, 1); PG8_SCHED; PG8_LDA(At, 0, 0);
            if (seam) { PG8_WAIT_VS(); } else { PG8_STAGE(PG8_SA(1, 1), a1 + hstep, voffA); PG8_WAIT_V(8); }
            PG8_WAIT_L(0); PG8_BAR; PG8_MMA(0, 0, At, B0); PG8_MMA(0, 1, At, B1); PG8_BAR; PG8_SCHED;
            PG8_LDA(At, 0, 1); PG8_STAGE(PG8_SB(0, 0), b2, voffB); PG8_STAGE(PG8_SB(0, 1), b2 + hstep, voffB); PG8_STAGE(PG8_SA(0, 0), a2, voffA);
            if (seam) PG8_WAIT_VS(); else PG8_WAIT_V(8);
            PG8_WAIT_L(0); PG8_BAR; PG8_MMA(1, 0, At, B0); PG8_MMA(1, 1, At, B1); PG8_BAR; PG8_SCHED;
            PG8_LDB(B0, 1, 0); PG8_LDB(B1, 1, 1); PG8_SCHED; PG8_LDA(At, 1, 0); PG8_STAGE(PG8_SA(0, 1), a2 + hstep, voffA);
            if (seam) PG8_WAIT_VS(); else PG8_WAIT_V(8);
            PG8_WAIT_L(0); PG8_BAR; PG8_MMA(0, 0, At, B0); PG8_MMA(0, 1, At, B1); PG8_BAR; PG8_SCHED;
            { const int a11 = aoff + (seam ? PG8_XSPARE : PG8_SA(1, 1)); PG8_LDA_OFF(At, a11); }
            PG8_STAGE(PG8_SB(1, 0), b3, voffB); PG8_STAGE(PG8_SB(1, 1), b3 + hstep, voffB); PG8_STAGE(PG8_SA(1, 0), a3, voffA);
            if (last && has_next) { PG8_STAGE(PG8_XSPARE, a3 + hstep, voffA); PG8_WAIT_V(10); } else PG8_WAIT_V(8);
            PG8_WAIT_L(0); PG8_BAR; PG8_MMA(1, 0, At, B0); PG8_MMA(1, 1, At, B1); PG8_BAR; PG8_SCHED;
            } else {
            PG8_LDB(B0, 0, 0); PG8_SCHED; PG8_LDA(At, 0, 0); PG8_STAGE(PG8_SA(1, 1), a1 + hstep, voffA);
            PG8_WAIT_L(8); PG8_BAR; PG8_WAIT_L(0); PG8_MMA(0, 0, At, B0); PG8_BAR; PG8_SCHED;
            PG8_LDB(B1, 0, 1); PG8_STAGE(PG8_SB(0, 0), b2, voffB);
            PG8_BAR; PG8_WAIT_L(0); PG8_MMA(0, 1, At, B1); PG8_BAR;
            PG8_LDA(At, 0, 1); PG8_STAGE(PG8_SA(0, 0), a2, voffA);
            PG8_BAR; PG8_WAIT_L(0); PG8_MMA(1, 0, At, B0); PG8_BAR; PG8_SCHED;
            PG8_STAGE(PG8_SB(0, 1), b2 + hstep, voffB);
            PG8_WAIT_V(6); PG8_BAR; PG8_MMA(1, 1, At, B1); PG8_BAR;
            PG8_LDB(B0, 1, 0); PG8_SCHED; PG8_LDA(At, 1, 0); PG8_STAGE(PG8_SA(0, 1), a2 + hstep, voffA);
            PG8_WAIT_L(8); PG8_BAR; PG8_WAIT_L(0); PG8_MMA(0, 0, At, B0); PG8_BAR; PG8_SCHED;
            PG8_LDB(B1, 1, 1); PG8_STAGE(PG8_SB(1, 0), b3, voffB);
            PG8_BAR; PG8_WAIT_L(0); PG8_MMA(0, 1, At, B1); PG8_BAR;
            PG8_LDA(At, 1, 1); PG8_STAGE(PG8_SA(1, 0), a3, voffA);
            PG8_BAR; PG8_WAIT_L(0); PG8_MMA(1, 0, At, B0); PG8_BAR; PG8_SCHED;
            PG8_STAGE(PG8_SB(1, 1), b3 + hstep, voffB);
            PG8_WAIT_V(6); PG8_BAR; PG8_MMA(1, 1, At, B1); PG8_BAR;
            }
        }
        PG8_PROBE_A(0);
        if constexpr (ALIGN_EPI) { if (wr == 0) PG8_BAR; }
        if constexpr (!Epi::AFTER_DRAIN) { E(acc, cur, wr, wc, fr, fq, lds); S.done(cur); }
        PG8_PROBE_A(1);
        if (!has_next) break;
#pragma unroll
        for (int a = 0; a < 2; ++a)
#pragma unroll
            for (int b = 0; b < 2; ++b)
#pragma unroll
                for (int m = 0; m < 4; ++m)
#pragma unroll
                    for (int n = 0; n < 2; ++n) acc[a][b][m][n] = (f32x4){0.f, 0.f, 0.f, 0.f};
        cur = nxt; cA = nA; cB = nB; ++ui; cur.par = ui & 1; E.stage(cur, lds, wid, lane);
        if constexpr (ALIGN_EPI) { if (wr == 1) PG8_BAR; }
    }
    PG8_WAIT_V(0);
    if constexpr (!ALIGN_EPI) { if (wr == 0) PG8_BAR; }
    PG8_BAR;
    if constexpr (Epi::AFTER_DRAIN) { E.fused(acc, cur, wr, wc, fr, fq, lds, wid, lane); S.done(cur); }
#undef PG8_SA
#undef PG8_SB
#undef PG8_STAGE
#undef PG8_LDA
#undef PG8_LDB
#undef PG8_MMA
#undef PG8_WAIT_V
#undef PG8_WAIT_VS
#undef PG8_LDA_OFF
#undef PG8_WAIT_L
#undef PG8_BAR
#undef PG8_SCHED
}
}
#define GAS __attribute__((address_space(1)))
#define LAS __attribute__((address_space(3)))
typedef unsigned short bf16;
typedef unsigned v4u __attribute__((ext_vector_type(4)));
typedef float f32x4 __attribute__((ext_vector_type(4)));
typedef short bf16x8 __attribute__((ext_vector_type(8)));
typedef GAS unsigned gu32;
typedef GAS unsigned long long gu64;
#define RLX_AGENT __ATOMIC_RELAXED, __HIP_MEMORY_SCOPE_AGENT
#define LDS_WAIT() asm volatile("s_waitcnt lgkmcnt(0)" ::: "memory")
#define VM_WAIT() asm volatile("s_waitcnt vmcnt(0)" ::: "memory")
__device__ __forceinline__ unsigned long long rt() { return __builtin_amdgcn_s_memrealtime(); }
__device__ __forceinline__ unsigned f2bf(float f) { unsigned u = __builtin_bit_cast(unsigned, f); return (u + 0x7fffu + ((u >> 16) & 1u)) >> 16; }
__device__ __forceinline__ unsigned pk2(float lo, float hi) { return f2bf(lo) | (f2bf(hi) << 16); }

#define XB_TMO      128
#define XB_XCNT(j)  (256  + 64 * (j))
#define XB_XSUB(j)  (1280 + 64 * (j))
#define XB_XGEN(j)  (2304 + 64 * (j))
#define XB_TOP      3328
#define XB_TOPGEN   3392
#define XCD_BAR_WORDS 3456
#define XB_SPIN_CAP (1u << 18)

__device__ __forceinline__ unsigned xb_ld(unsigned* p)              { return __hip_atomic_load(p, __ATOMIC_RELAXED, __HIP_MEMORY_SCOPE_AGENT); }
__device__ __forceinline__ unsigned xb_add(unsigned* p, unsigned v) { return __hip_atomic_fetch_add(p, v, __ATOMIC_RELAXED, __HIP_MEMORY_SCOPE_AGENT); }
__device__ __forceinline__ unsigned xb_xcc_id() { return (unsigned)__builtin_amdgcn_s_getreg((3 << 11) | 20) & 0xFu; }
#define XB_SPIN(cond, bar) do { unsigned _sp = 0; while (cond) { __builtin_amdgcn_s_sleep(1); \
    if ((++_sp & 255u) == 0u) { if (xb_ld(&(bar)[XB_TMO])) break; if (_sp > XB_SPIN_CAP) { atomicAdd(&(bar)[XB_TMO], 1u); break; } } } } while (0)

struct XcdBarrier {
    unsigned* bar; unsigned x;
    volatile LAS unsigned* st;
};

__device__ __forceinline__ XcdBarrier xcd_barrier_post(unsigned* bar, volatile LAS unsigned* st) {
    XcdBarrier b; b.bar = bar; b.x = xb_xcc_id(); b.st = st;
    if (threadIdx.x == 0) (void)xb_add(&bar[XB_XCNT(b.x)], 1u);
    return b;
}
__device__ __forceinline__ void xcd_barrier_complete(unsigned* bar, unsigned x, unsigned& nloc, unsigned& nx) {
    const unsigned G = gridDim.x * gridDim.y * gridDim.z;
    unsigned sum, cnt, mine, sp = 0u;
    for (;;) {
        sum = 0u; cnt = 0u; mine = 0u;
#pragma unroll
        for (unsigned j = 0; j < 16; ++j) { const unsigned c = xb_ld(&bar[XB_XCNT(j)]); sum += c; cnt += (c > 0u) ? 1u : 0u; mine = (j == x) ? c : mine; }
        if (sum == G) break;
        __builtin_amdgcn_s_sleep(1);
        if ((++sp & 255u) == 0u) { if (xb_ld(&bar[XB_TMO])) break; if (sp > XB_SPIN_CAP) { atomicAdd(&bar[XB_TMO], 1u); break; } }
    }
    nloc = mine > 0u ? mine : 1u; nx = cnt > 0u ? cnt : 1u;
}

__device__ __forceinline__ void xcd_barrier(const XcdBarrier& b) {
    asm volatile("s_waitcnt vmcnt(0)" ::: "memory");
    __syncthreads();
    if (threadIdx.x == 0) {
        unsigned* bar = b.bar;
        __builtin_amdgcn_s_waitcnt(0);
        unsigned nloc = b.st[0], nx = b.st[1];
        if (nloc == 0u) { xcd_barrier_complete(bar, b.x, nloc, nx); b.st[0] = nloc; b.st[1] = nx; }
        const unsigned old = xb_add(&bar[XB_XSUB(b.x)], 1u);
        const unsigned gen = old / nloc;
        if (old + 1u == (gen + 1u) * nloc) {
            __builtin_amdgcn_fence(__ATOMIC_RELEASE, "agent");
            asm volatile("s_waitcnt vmcnt(0)" ::: "memory");
            const unsigned og = xb_add(&bar[XB_TOP], 1u);
            const unsigned tg = og / nx;
            if (og + 1u == (tg + 1u) * nx) xb_add(&bar[XB_TOPGEN], 1u);
            else XB_SPIN(xb_ld(&bar[XB_TOPGEN]) == tg, bar);
            __builtin_amdgcn_fence(__ATOMIC_ACQUIRE, "agent");
            xb_add(&bar[XB_XGEN(b.x)], 1u);
            asm volatile("s_waitcnt vmcnt(0)" ::: "memory");
        } else {
            XB_SPIN(xb_ld(&bar[XB_XGEN(b.x)]) == gen, bar);
            __builtin_amdgcn_fence(__ATOMIC_ACQUIRE, "agent");
            asm volatile("s_waitcnt vmcnt(0)" ::: "memory");
        }
    }
    __syncthreads();
}

constexpr int DM = 2048, NBATCH = 2, SEQ = 8192, NL = 4, DECB = 8, DECS = 16, PAST = 2048;
constexpr int MP = NBATCH * SEQ;
constexpr int MS = DECB * DECS;
constexpr int MR = MP + MS;
constexpr int MT = 16640;
constexpr int INW = 5648, NIN = 5888, FF = 5632, NGU = 2 * FF;
constexpr int C_CU = 0, C_CV = 512, C_GQ = 1024, C_GK = 1280, C_GV = 1536, C_GR = 2048, C_SQ = 2560, C_SK = 3584, C_SV = 4608, C_LR = 5632;
constexpr float EPS = 1e-6f;
constexpr float QSCALE = 0.08838834764831845f * 1.4426950408889634f;

constexpr size_t O_Y = 0;
constexpr size_t O_KP = (size_t)MR * DM;
constexpr size_t O_VP = O_KP + (size_t)NL * MP * 1024;
constexpr size_t O_GP = O_VP + (size_t)NL * MP * 1024;
constexpr size_t O_CP = O_GP + (size_t)NL * NBATCH * 4 * 64 * 128;
constexpr size_t O_KS = O_CP + (size_t)NL * NBATCH * 2 * FF;
constexpr size_t O_VS = O_KS + (size_t)NL * MS * 1024;
constexpr size_t O_GS = O_VS + (size_t)NL * MS * 1024;
constexpr size_t O_CS = O_GS + (size_t)NL * DECB * 4 * 64 * 128;
constexpr size_t O_CM = O_CS + (size_t)NL * DECB * 2 * FF;
constexpr size_t O_END = O_CM + (size_t)NL * MS * 512;

constexpr size_t MiB = 1u << 20;
constexpr size_t WS_CTL = 0, CTL_ZERO_BYTES = 1 * MiB;
constexpr size_t SZ_WIN = (size_t)NIN * DM * 2, SZ_WOUT = (size_t)DM * DM * 2, SZ_WGU = (size_t)NGU * DM * 2, SZ_WDN = (size_t)DM * FF * 2;
constexpr size_t SZ_WL = SZ_WIN + SZ_WOUT + SZ_WGU + SZ_WDN;
constexpr size_t WS_W = 1 * MiB;
constexpr size_t WS_H = WS_W + NL * SZ_WL;
constexpr size_t WS_HID = WS_H + (size_t)MT * DM * 2;
constexpr size_t WS_RA = WS_HID + (size_t)MT * FF * 2;
constexpr size_t WS_PROJ = WS_RA;
constexpr size_t WS_MIX = WS_PROJ + (size_t)MT * NIN * 2;
constexpr size_t WS_GLAU = WS_MIX + (size_t)MT * DM * 2;
constexpr size_t WS_GLAD = WS_GLAU + (size_t)1024 * 8192 * 4;
constexpr size_t WS_GH = WS_GLAD + (size_t)1024 * 64 * 4;
constexpr size_t WS_SBR = WS_GH + (size_t)260 * 2 * FF * 4;
constexpr size_t WS_PART = WS_SBR + (size_t)256 * 2 * 2 * FF * 4;
constexpr int NP_OUT = DM / 256, NP_DN = FF / 256;
constexpr size_t WS_SS1 = WS_PART + (size_t)NP_DN * 128 * DM * 4;
constexpr size_t WS_SS2 = WS_SS1 + (size_t)MT * 4;
constexpr size_t WS_SSP = WS_SS2 + (size_t)MT * 4;
constexpr int GU_PNT = 8, NP_GU = DM / (GU_PNT * 64);
constexpr size_t WS_PGU = WS_SSP + (size_t)MP * 32 * 4;
constexpr size_t WS_GLAF = WS_PGU + (size_t)NP_GU * 128 * NGU * 4;
constexpr size_t WS_END = WS_GLAF + (size_t)1024 * 36864;
static_assert(WS_W % 256 == 0 && SZ_WL % 256 == 0 && WS_H % 256 == 0 && WS_HID % 256 == 0 && WS_RA % 256 == 0 && WS_MIX % 256 == 0 && WS_GLAU % 256 == 0 && WS_GH % 256 == 0 && WS_SBR % 256 == 0, "alignment");

constexpr int CW_BAR = 4096;
constexpr int CW_Q = 16384;
static_assert((CW_Q + 64 * 64) * 4 <= (int)CTL_ZERO_BYTES, "ctl");

constexpr int SCR_BYTES = 139264;
constexpr int LCTL_OFF = SCR_BYTES;
constexpr int LDS_BYTES = 163840;
static_assert(LCTL_OFF + 256 <= LDS_BYTES, "lds");
constexpr int NWAVES = 8, NTHR = 512;
#ifndef WGM_IN
#define WGM_IN 4
#define WGM_OUT 4
#define WGM_GU 4
#define WGM_DN 4
#endif

struct Args { const float* in[22]; float* out; unsigned char* ws; };
typedef const __attribute__((address_space(4))) Args* KArgs;
__device__ __forceinline__ KArgs kargs() { KArgs p = (KArgs)__builtin_amdgcn_kernarg_segment_ptr(); asm volatile("" : "+s"(p)); return p; }
__device__ __forceinline__ int fresh_tid() { int t = threadIdx.x; asm volatile("" : "+v"(t)); return t; }
__device__ __forceinline__ int fresh_bx() { int t = blockIdx.x; asm volatile("" : "+s"(t)); return t; }


__device__ __forceinline__ float bf_lo(unsigned w) { return __uint_as_float(w << 16); }
__device__ __forceinline__ float bf_hi(unsigned w) { return __uint_as_float(w & 0xffff0000u); }
__device__ __forceinline__ unsigned pkbf(float lo, float hi) { return pg8::cvt_pk_bf16(lo, hi); }
__device__ __forceinline__ float gelu_t(float x) { const float in = x + 0.044715f * x * x * x; return x * __builtin_amdgcn_rcpf(1.f + __expf(-1.5957691216057308f * in)); }
__device__ __forceinline__ float silu_f(float x) { return x * __builtin_amdgcn_rcpf(1.f + __expf(-x)); }
__device__ __forceinline__ float logsig_f(float x) { return fminf(x, 0.f) - __logf(1.f + __expf(-fabsf(x))); }
typedef float f32x2 __attribute__((ext_vector_type(2)));
template <int M> __device__ __forceinline__ float shx(float v) { static_assert(M >= 1 && M < 32, "shx"); return __int_as_float(__builtin_amdgcn_ds_swizzle(__float_as_int(v), 0x1f | (M << 10))); }
__device__ __forceinline__ float sum_x32(float v) { auto rr = __builtin_amdgcn_permlane32_swap(__float_as_uint(v), __float_as_uint(v), false, false); return __uint_as_float(rr[0]) + __uint_as_float(rr[1]); }
__device__ __forceinline__ float bperm(float v, int srclane) { return __int_as_float(__builtin_amdgcn_ds_bpermute(srclane << 2, __float_as_int(v))); }
using pg8::u32x2;

struct CvItem { const float* W; const float* gk; bf16* WT; int ldw, sc, nv, k0, K, dr; };
constexpr int IT_WIN = (DM / 64) * (NIN / 64), IT_WOUT = (DM / 64) * (DM / 64), IT_WG = (DM / 64) * (FF / 64), IT_WD = (FF / 64) * (DM / 64);
constexpr int IT_L = IT_WIN + IT_WOUT + 2 * IT_WG + IT_WD;
__device__ __forceinline__ CvItem cv_decode(KArgs a, unsigned char* ws, int l, int r) {
    unsigned char* wl = ws + WS_W + (size_t)l * SZ_WL;
    CvItem c; c.gk = nullptr; c.nv = 64; c.K = DM;
    if (r < IT_WIN) { const int nblk = NIN / 64, kb = r / nblk, nb = r - kb * nblk, d0 = nb * 64;
        if (d0 < 2560) { c.sc = d0; } else if (d0 < 5632) { c.sc = d0 + 16; } else if (d0 == 5632) { c.sc = 2560; c.nv = 16; } else { c.sc = 0; c.nv = 0; }
        c.W = a->in[7] + (size_t)l * DM * INW; c.ldw = INW; c.k0 = kb * 64; c.WT = (bf16*)wl; c.dr = d0; c.gk = a->in[6] + (size_t)l * DM; }
    else if (r < IT_WIN + IT_WOUT) { r -= IT_WIN; const int nblk = DM / 64, kb = r / nblk, nb = r - kb * nblk;
        c.W = a->in[15] + (size_t)l * DM * DM; c.ldw = DM; c.sc = nb * 64; c.k0 = kb * 64; c.WT = (bf16*)(wl + SZ_WIN); c.dr = nb * 64; }
    else if (r < IT_WIN + IT_WOUT + 2 * IT_WG) { r -= IT_WIN + IT_WOUT; const int up = r >= IT_WG ? 1 : 0; r -= up * IT_WG; const int nblk = FF / 64, kb = r / nblk, nb = r - kb * nblk, f0 = nb * 64;
        c.W = (up ? a->in[18] : a->in[17]) + (size_t)l * DM * FF; c.ldw = FF; c.sc = f0; c.k0 = kb * 64; c.WT = (bf16*)(wl + SZ_WIN + SZ_WOUT); c.dr = (f0 >> 7) * 256 + (f0 & 127) + up * 128; c.gk = a->in[16] + (size_t)l * DM; }
    else { r -= IT_WIN + IT_WOUT + 2 * IT_WG; const int nblk = DM / 64, kb = r / nblk, nb = r - kb * nblk;
        c.W = a->in[21] + (size_t)l * FF * DM; c.ldw = DM; c.sc = nb * 64; c.k0 = kb * 64; c.WT = (bf16*)(wl + SZ_WIN + SZ_WOUT + SZ_WGU); c.K = FF; c.dr = nb * 64; }
    return c;
}
__device__ __forceinline__ void cv_load(const CvItem& c, int lane, f32x4 (&v)[16], f32x4& g0, f32x4& g1) {
    const int c4 = (lane & 15) * 4, kr = lane >> 4;
    g0 = (f32x4){1.f, 1.f, 1.f, 1.f}; g1 = g0; if (c.gk) { g0 = *(const GAS f32x4*)(c.gk + c.k0 + 8 * (lane & 7)); g1 = *(const GAS f32x4*)(c.gk + c.k0 + 8 * (lane & 7) + 4); }
    const float* wp = c.W + (size_t)(c.k0 + kr) * c.ldw + c.sc + (c4 < c.nv ? c4 : 0);
#pragma unroll
    for (int i = 0; i < 16; ++i) v[i] = *(const GAS f32x4*)(wp + (size_t)(4 * i) * c.ldw);
}
__device__ __forceinline__ void cv_to_lds(const CvItem& c, LAS float* scr, int lane, const f32x4 (&v)[16]) {
    const int c4 = (lane & 15) * 4, kr = lane >> 4; const bool ok = c4 < c.nv;
#pragma unroll
    for (int i = 0; i < 16; ++i) { LAS float* d = scr + (4 * i + kr) * 65 + c4; const f32x4 x = ok ? v[i] : (f32x4){0.f, 0.f, 0.f, 0.f}; d[0] = x.x; d[1] = x.y; d[2] = x.z; d[3] = x.w; }
    LDS_WAIT(); asm volatile("" ::: "memory");
}
__device__ __forceinline__ void cv_emit(const CvItem& c, LAS float* scr, int lane, const f32x4 g0, const f32x4 g1) {
    const int cc = lane & 7;
#pragma unroll
    for (int jj = 0; jj < 8; ++jj) { const int n = (lane >> 3) + 8 * jj; const LAS float* s = scr + (8 * cc) * 65 + n;
        v4u o; o.x = pkbf(s[0 * 65] * g0.x, s[1 * 65] * g0.y); o.y = pkbf(s[2 * 65] * g0.z, s[3 * 65] * g0.w); o.z = pkbf(s[4 * 65] * g1.x, s[5 * 65] * g1.y); o.w = pkbf(s[6 * 65] * g1.z, s[7 * 65] * g1.w);
        *(GAS v4u*)(c.WT + (size_t)(c.dr + n) * c.K + c.k0 + 8 * cc) = o; }
    LDS_WAIT(); asm volatile("" ::: "memory");
}
__device__ __forceinline__ void p0_prologue(KArgs a, LAS unsigned char* lds, int gw, int NGW, int wave, int lane, int gtid, int GT) {
    LAS float* scr = (LAS float*)(lds + wave * 16640);
    unsigned char* ws = a->ws;
    if (gw < NL * IT_L) {
        f32x4 v[16], gc0, gc1, gn0, gn1; CvItem cur = cv_decode(a, ws, gw / IT_L, gw % IT_L); cv_load(cur, lane, v, gc0, gc1);
        for (int it = gw; it < NL * IT_L; it += NGW) {
            cv_to_lds(cur, scr, lane, v);
            const int itn = it + NGW; CvItem nxt = cur; gn0 = gc0; gn1 = gc1;
            if (itn < NL * IT_L) { nxt = cv_decode(a, ws, itn / IT_L, itn % IT_L); cv_load(nxt, lane, v, gn0, gn1); }
            cv_emit(cur, scr, lane, gc0, gc1);
            cur = nxt; gc0 = gn0; gc1 = gn1;
        }
    }
    for (int m = gw; m < MR; m += NGW) {
        const float* src = m < MP ? a->in[0] + (size_t)m * DM : a->in[1] + (size_t)(m - MP) * DM;
        const GAS f32x4* s4 = (const GAS f32x4*)src + lane; GAS f32x4* d4 = (GAS f32x4*)(a->out + (size_t)m * DM) + lane; GAS u32x2* b4 = (GAS u32x2*)(ws + WS_H + (size_t)m * DM * 2) + lane;
        float ss = 0.f; f32x4 vv[8];
#pragma unroll
        for (int j = 0; j < 8; ++j) vv[j] = s4[64 * j];
#pragma unroll
        for (int j = 0; j < 8; ++j) { const f32x4 v = vv[j]; if (m >= MP) d4[64 * j] = v; u32x2 w; w.x = pkbf(v.x, v.y); w.y = pkbf(v.z, v.w); b4[64 * j] = w; ss += (v.x * v.x + v.y * v.y) + (v.z * v.z + v.w * v.w); }
        ss += shx<1>(ss); ss += shx<2>(ss); ss += shx<4>(ss); ss += shx<8>(ss); ss += shx<16>(ss); ss = sum_x32(ss);
        if (lane == 0) ((float*)(ws + WS_SS1))[m] = ss;
    }
    for (int i = gtid; i < MT; i += GT) { ((float*)(ws + WS_SS2))[i] = 0.f; if (i >= MR) ((float*)(ws + WS_SS1))[i] = 0.f; }
    { const v4u z = {0u, 0u, 0u, 0u};
      const int nH = (MT - MR) * DM * 2 / 16, nF = (MT - MR) * FF * 2 / 16;
      GAS v4u* pH = (GAS v4u*)(ws + WS_H + (size_t)MR * DM * 2); GAS v4u* pM = (GAS v4u*)(ws + WS_MIX + (size_t)MR * DM * 2); GAS v4u* pF = (GAS v4u*)(ws + WS_HID + (size_t)MR * FF * 2);
      for (int i = gtid; i < nH; i += GT) { pH[i] = z; pM[i] = z; }
      for (int i = gtid; i < nF; i += GT) pF[i] = z; }
}

__device__ __forceinline__ void sample_rows_phase(float* X, bf16* XB, float* SSo, const float* SSP, const float* PART, int np, LAS unsigned char* lds, int bx, int G, int tid) {
    const int wave = tid >> 6, lane = tid & 63;
    for (int rs = bx; rs < MS; rs += G) {
        const int m = MP + rs;
        GAS f32x4* xr = (GAS f32x4*)(X + (size_t)m * DM) + tid;
        f32x4 v = *xr;
        f32x4 acc = {0.f, 0.f, 0.f, 0.f};
#pragma unroll 11
        for (int p = 0; p < np; ++p) acc += *((const GAS f32x4*)(PART + ((size_t)p * 128 + rs) * DM) + tid);
        v += acc;
        if (np > 0) *xr = v;
        float ss = (v.x * v.x + v.y * v.y) + (v.z * v.z + v.w * v.w);
        ss += shx<1>(ss); ss += shx<2>(ss); ss += shx<4>(ss); ss += shx<8>(ss); ss += shx<16>(ss); ss = sum_x32(ss);
        if (XB) { u32x2 w; w.x = pkbf(v.x, v.y); w.y = pkbf(v.z, v.w); *((GAS u32x2*)(XB + (size_t)m * DM) + tid) = w;
            LAS float* red = (LAS float*)lds;
            __syncthreads();
            if (lane == 0) red[wave] = ss;
            __syncthreads();
            if (tid == 0) SSo[m] = ((red[0] + red[1]) + (red[2] + red[3])) + ((red[4] + red[5]) + (red[6] + red[7])); }
    }
    if (SSP) { const int nb = G > MS ? G - MS : G, b0 = G > MS ? bx - MS : bx;
        if (b0 >= 0) for (int r = b0 * NTHR + tid; r < MP; r += nb * NTHR) { const GAS f32x4* p = (const GAS f32x4*)(SSP + (size_t)r * 32); float s = 0.f;
#pragma unroll
            for (int k = 0; k < 8; ++k) { const f32x4 q = p[k]; s += (q.x + q.y) + (q.z + q.w); }
            SSo[r] = s; } }
}

__device__ __forceinline__ void unpack16(const v4u a, const v4u b, float (&x)[16]) {
    x[0] = bf_lo(a.x); x[1] = bf_hi(a.x); x[2] = bf_lo(a.y); x[3] = bf_hi(a.y); x[4] = bf_lo(a.z); x[5] = bf_hi(a.z); x[6] = bf_lo(a.w); x[7] = bf_hi(a.w);
    x[8] = bf_lo(b.x); x[9] = bf_hi(b.x); x[10] = bf_lo(b.y); x[11] = bf_hi(b.y); x[12] = bf_lo(b.z); x[13] = bf_hi(b.z); x[14] = bf_lo(b.w); x[15] = bf_hi(b.w);
}
__device__ __forceinline__ void unpack8(const v4u a, float (&x)[8]) {
    x[0] = bf_lo(a.x); x[1] = bf_hi(a.x); x[2] = bf_lo(a.y); x[3] = bf_hi(a.y); x[4] = bf_lo(a.z); x[5] = bf_hi(a.z); x[6] = bf_lo(a.w); x[7] = bf_hi(a.w);
}
__device__ __forceinline__ v4u pack8f(const float (&x)[8]) { v4u o; o.x = pkbf(x[0], x[1]); o.y = pkbf(x[2], x[3]); o.z = pkbf(x[4], x[5]); o.w = pkbf(x[6], x[7]); return o; }

constexpr int GSEG = 2, NGLA_P = 8 * (128 / GSEG);
constexpr int GB_CUM = 0;
constexpr int GB_GS = 17408;
constexpr int GB_DV = 19456;
constexpr int GB_SSQ = 19712;
constexpr int GB_QE = 20480;
constexpr int GB_KE = 29696;
constexpr int GB_KDT = 38912;
constexpr int GB_ATT = 48128;
constexpr int GB_VT = 57344;
constexpr int GB_ST = 75776;
static_assert(GB_ST + 128 * 72 * 2 <= SCR_BYTES, "gla lds");
typedef LAS unsigned char* lbytes;
__device__ __forceinline__ unsigned short bf1(float x) { return (unsigned short)(pkbf(x, 0.f) & 0xffffu); }
__device__ __forceinline__ bf16x8 ldfrag(lbytes L, int off) { return *(const LAS bf16x8*)(L + off); }

__device__ __forceinline__ void gla_front(lbytes L, const bf16* PROJ, int r0, int nrows, int h, const float* __restrict__ w2l, const float* __restrict__ bl, int tid) {
    LAS float* CUM = (LAS float*)(L + GB_CUM); LAS float* GS = (LAS float*)(L + GB_GS);
    __syncthreads();
    v4u qraw = {0u, 0u, 0u, 0u}, kraw = {0u, 0u, 0u, 0u};
    { const int s = tid >> 3, c = tid & 7; const bool ok = s < nrows; const bf16* prow = PROJ + (size_t)(r0 + s) * NIN;
      if (ok) { qraw = *(const GAS v4u*)(prow + C_GQ + h * 64 + c * 8); kraw = *(const GAS v4u*)(prow + C_GK + h * 64 + c * 8); }
      { float x[16]; if (ok) { const GAS v4u* p = (const GAS v4u*)(prow + C_GV + h * 128 + c * 16); unpack16(p[0], p[1], x); } else {
#pragma unroll
            for (int i = 0; i < 16; ++i) x[i] = 0.f; }
        LAS unsigned short* vt = (LAS unsigned short*)(L + GB_VT) + (c * 16) * 72 + s;
#pragma unroll
        for (int i = 0; i < 16; ++i) vt[i * 72] = bf1(x[i]); }
      { float acc[8];
#pragma unroll
        for (int i = 0; i < 8; ++i) acc[i] = 0.f;
        if (ok) { float g[16]; { const GAS v4u* p = (const GAS v4u*)(prow + C_LR); unpack16(p[0], p[1], g); }
            const int d0 = h * 64 + c * 8;
#pragma unroll
            for (int i = 0; i < 8; ++i) acc[i] = bl[d0 + i];
#pragma unroll
            for (int j = 0; j < 16; ++j) { const GAS f32x4* w = (const GAS f32x4*)(w2l + j * 256 + d0); const f32x4 w0 = w[0], w1 = w[1];
                acc[0] += g[j] * w0.x; acc[1] += g[j] * w0.y; acc[2] += g[j] * w0.z; acc[3] += g[j] * w0.w; acc[4] += g[j] * w1.x; acc[5] += g[j] * w1.y; acc[6] += g[j] * w1.z; acc[7] += g[j] * w1.w; }
#pragma unroll
            for (int i = 0; i < 8; ++i) acc[i] = logsig_f(acc[i]) * (1.f / 16.f); }
        LAS f32x4* d = (LAS f32x4*)(CUM + s * 68 + c * 8); d[0] = (f32x4){acc[0], acc[1], acc[2], acc[3]}; d[1] = (f32x4){acc[4], acc[5], acc[6], acc[7]}; } }
    __syncthreads();
    { const int d = tid & 63, sg = tid >> 6; float x[8]; float run = 0.f;
#pragma unroll
      for (int i = 0; i < 8; ++i) { run += CUM[(sg * 8 + i) * 68 + d]; x[i] = run; }
      GS[sg * 64 + d] = run;
      __syncthreads();
      float off = 0.f;
#pragma unroll
      for (int g = 0; g < 8; ++g) { const float t = GS[g * 64 + d]; off += (g < sg) ? t : 0.f; }
#pragma unroll
      for (int i = 0; i < 8; ++i) CUM[(sg * 8 + i) * 68 + d] = x[i] + off; }
    __syncthreads();
    { const int s = tid >> 3, c = tid & 7, d0 = c * 8;
      float q[8], k[8]; unpack8(qraw, q); unpack8(kraw, k);
      const LAS f32x4* cp = (const LAS f32x4*)(CUM + s * 68 + d0); const LAS f32x4* lp = (const LAS f32x4*)(CUM + 63 * 68 + d0);
      const f32x4 c0 = cp[0], c1 = cp[1], l0 = lp[0], l1 = lp[1];
      const float cum[8] = {c0.x, c0.y, c0.z, c0.w, c1.x, c1.y, c1.z, c1.w}, last[8] = {l0.x, l0.y, l0.z, l0.w, l1.x, l1.y, l1.z, l1.w};
      float qe[8], ke[8];
      LAS unsigned short* kdt = (LAS unsigned short*)(L + GB_KDT) + d0 * 72 + s;
#pragma unroll
      for (int i = 0; i < 8; ++i) { qe[i] = q[i] * __expf(cum[i]) * 0.125f; ke[i] = k[i] * __expf(-cum[i]); kdt[i * 72] = bf1(k[i] * __expf(last[i] - cum[i])); }
      *(LAS v4u*)(L + GB_QE + s * 144 + d0 * 2) = pack8f(qe); *(LAS v4u*)(L + GB_KE + s * 144 + d0 * 2) = pack8f(ke);
      if (s == 0) { LAS float* DV = (LAS float*)(L + GB_DV);
#pragma unroll
          for (int i = 0; i < 8; ++i) DV[d0 + i] = __expf(last[i]); } }
    __syncthreads();
}
__device__ __forceinline__ void gla_U(lbytes L, int wv, int r, int quad, f32x4 (&u)[4]) {
    const int td = wv >> 1, te0 = (wv & 1) * 4;
    const bf16x8 a0 = ldfrag(L, GB_KDT + (16 * td + r) * 144 + quad * 16), a1 = ldfrag(L, GB_KDT + (16 * td + r) * 144 + 64 + quad * 16);
#pragma unroll
    for (int j = 0; j < 4; ++j) { const int vo = GB_VT + (16 * (te0 + j) + r) * 144 + quad * 16;
        f32x4 acc = {0.f, 0.f, 0.f, 0.f};
        acc = __builtin_amdgcn_mfma_f32_16x16x32_bf16(a0, ldfrag(L, vo), acc, 0, 0, 0);
        acc = __builtin_amdgcn_mfma_f32_16x16x32_bf16(a1, ldfrag(L, vo + 64), acc, 0, 0, 0);
        u[j] = acc; }
}
__device__ __forceinline__ void gla_att(lbytes L, int wv, int r, int quad) {
    const int tt = wv >> 1; const bf16x8 a0 = ldfrag(L, GB_QE + (16 * tt + r) * 144 + quad * 16), a1 = ldfrag(L, GB_QE + (16 * tt + r) * 144 + 64 + quad * 16);
#pragma unroll
    for (int jj = 0; jj < 2; ++jj) { const int ts = 2 * (wv & 1) + jj; f32x4 acc = {0.f, 0.f, 0.f, 0.f};
        if (ts <= tt) { const int ko = GB_KE + (16 * ts + r) * 144 + quad * 16;
            acc = __builtin_amdgcn_mfma_f32_16x16x32_bf16(a0, ldfrag(L, ko), acc, 0, 0, 0);
            acc = __builtin_amdgcn_mfma_f32_16x16x32_bf16(a1, ldfrag(L, ko + 64), acc, 0, 0, 0); }
        LAS unsigned short* at = (LAS unsigned short*)(L + GB_ATT) + (16 * tt + 4 * quad) * 72 + 16 * ts + r;
#pragma unroll
        for (int g = 0; g < 4; ++g) at[g * 72] = bf1((16 * ts + r <= 16 * tt + 4 * quad + g) ? acc[g] : 0.f); }
}
constexpr int GF_BYTES = 9216 + 9216 + 18432;
__device__ __forceinline__ void gla_prep_item(lbytes L, const bf16* PROJ, int idx  , const float* w2l, const float* bl, float* GU, float* GD, unsigned char* GF, int tid) {
    const int c = idx & 127, bh = idx >> 7, b = bh >> 2, h = bh & 3;
    const int wv = __builtin_amdgcn_readfirstlane(tid >> 6), lane = tid & 63, r = lane & 15, quad = lane >> 4;
    gla_front(L, PROJ, b * SEQ + c * 64, 64, h, w2l, bl, tid);
    f32x4 u[4]; gla_U(L, wv, r, quad, u);
    gla_att(L, wv, r, quad);
    const int d0 = 16 * (wv >> 1) + 4 * quad, e0 = 64 * (wv & 1) + r;
#pragma unroll
    for (int j = 0; j < 4; ++j)
#pragma unroll
        for (int g = 0; g < 4; ++g) GU[((size_t)idx * 64 + d0 + g) * 128 + e0 + 16 * j] = u[j][g];
    if (tid < 64) GD[(size_t)idx * 64 + tid] = ((const LAS float*)(L + GB_DV))[tid];
    __syncthreads();
    { GAS v4u* dst = (GAS v4u*)(GF + (size_t)idx * GF_BYTES);
      for (int i = tid; i < GF_BYTES / 16; i += NTHR) { const int off = i < 576 ? GB_QE + i * 16 : i < 1152 ? GB_ATT + (i - 576) * 16 : GB_VT + (i - 1152) * 16; dst[i] = *(const LAS v4u*)(L + off); } }
}
__device__ __forceinline__ void gla_chunk_item(lbytes L, const bf16* PROJ, bf16* MIX, int idx, int l, KArgs a, const float* GU, const unsigned char* GF, int tid) {
    const float* gn = a->in[12] + (size_t)l * 512;
    const int c = idx & 127, bh = idx >> 7, h = bh & 3, r0 = (bh >> 2) * SEQ + c * 64;
    const int wv = __builtin_amdgcn_readfirstlane(tid >> 6), lane = tid & 63, r = lane & 15, quad = lane >> 4;
    const int td = wv >> 1, te0 = (wv & 1) * 4, d0 = 16 * td + 4 * quad, e0 = 64 * (wv & 1) + r;
    __syncthreads();
    v4u img[5]; { const GAS v4u* src = (const GAS v4u*)(GF + (size_t)idx * GF_BYTES);
#pragma unroll
        for (int k = 0; k < 5; ++k) { const int i = tid + k * NTHR; img[k] = i < GF_BYTES / 16 ? src[i] : (v4u){0u, 0u, 0u, 0u}; } }
    f32x4 S[4]; { const float* s0 = GU + (size_t)idx * 8192;
#pragma unroll
        for (int j = 0; j < 4; ++j)
#pragma unroll
            for (int g = 0; g < 4; ++g) S[j][g] = s0[(d0 + g) * 128 + e0 + 16 * j]; }
    unsigned short grv[4][4]; float gnv[4];
#pragma unroll
    for (int j = 0; j < 4; ++j) gnv[j] = gn[h * 128 + e0 + 16 * j];
#pragma unroll
    for (int g = 0; g < 4; ++g) { const bf16* grp = PROJ + (size_t)(r0 + d0 + g) * NIN + C_GR + h * 128 + e0;
#pragma unroll
        for (int j = 0; j < 4; ++j) grv[g][j] = grp[16 * j]; }
#pragma unroll
    for (int k = 0; k < 5; ++k) { const int i = tid + k * NTHR; if (i < GF_BYTES / 16) { const int off = i < 576 ? GB_QE + i * 16 : i < 1152 ? GB_ATT + (i - 576) * 16 : GB_VT + (i - 1152) * 16; *(LAS v4u*)(L + off) = img[k]; } }
#pragma unroll
    for (int j = 0; j < 4; ++j) { u32x2 w; w.x = pkbf(S[j][0], S[j][1]); w.y = pkbf(S[j][2], S[j][3]); *(LAS u32x2*)(L + GB_ST + (e0 + 16 * j) * 144 + d0 * 2) = w; }
    __syncthreads();
    f32x4 o[4];
    { const int ao = (16 * td + r) * 144 + quad * 16;
      const bf16x8 p0 = ldfrag(L, GB_ATT + ao), p1 = ldfrag(L, GB_ATT + ao + 64), q0 = ldfrag(L, GB_QE + ao), q1 = ldfrag(L, GB_QE + ao + 64);
#pragma unroll
      for (int j = 0; j < 4; ++j) { const int bo = (16 * (te0 + j) + r) * 144 + quad * 16; f32x4 acc = {0.f, 0.f, 0.f, 0.f};
          acc = __builtin_amdgcn_mfma_f32_16x16x32_bf16(p0, ldfrag(L, GB_VT + bo), acc, 0, 0, 0);
          acc = __builtin_amdgcn_mfma_f32_16x16x32_bf16(p1, ldfrag(L, GB_VT + bo + 64), acc, 0, 0, 0);
          acc = __builtin_amdgcn_mfma_f32_16x16x32_bf16(q0, ldfrag(L, GB_ST + bo), acc, 0, 0, 0);
          acc = __builtin_amdgcn_mfma_f32_16x16x32_bf16(q1, ldfrag(L, GB_ST + bo + 64), acc, 0, 0, 0);
          o[j] = acc; } }
    { LAS float* SSQ = (LAS float*)(L + GB_SSQ); f32x4 sp;
#pragma unroll
      for (int g = 0; g < 4; ++g) { float s = (o[0][g] * o[0][g] + o[1][g] * o[1][g]) + (o[2][g] * o[2][g] + o[3][g] * o[3][g]); s += shx<1>(s); s += shx<2>(s); s += shx<4>(s); s += shx<8>(s); sp[g] = s; }
      if (r == 0) {
#pragma unroll
          for (int g = 0; g < 4; ++g) SSQ[(d0 + g) * 2 + (wv & 1)] = sp[g]; }
      __syncthreads();
#pragma unroll
      for (int g = 0; g < 4; ++g) { const int t = d0 + g; const float rs = rsqrtf((SSQ[t * 2] + SSQ[t * 2 + 1]) * (1.f / 128.f) + EPS);
          bf16* mp = MIX + (size_t)(r0 + t) * DM + 512 + h * 128 + e0;
#pragma unroll
          for (int j = 0; j < 4; ++j) { const float gr = __uint_as_float(((unsigned)grv[g][j]) << 16); mp[16 * j] = bf1(o[j][g] * rs * gnv[j] * silu_f(gr)); } } }
}
__device__ __forceinline__ void gla_mix_item(lbytes L, const bf16* PROJ, bf16* MIX, int item, int l, KArgs a, const float* GU, const float* GD, int tid) {
    const float* w2l = a->in[10] + (size_t)l * 16 * 256; const float* bl = a->in[11] + (size_t)l * 256; const float* gn = a->in[12] + (size_t)l * 512;
    const int wv = __builtin_amdgcn_readfirstlane(tid >> 6), lane = tid & 63, r = lane & 15, quad = lane >> 4;
    const int td = wv >> 1, te0 = (wv & 1) * 4, d0 = 16 * td + 4 * quad, e0 = 64 * (wv & 1) + r;
    const bool samp = item >= NGLA_P;
    int h, rbase, nch, nrows, sb = 0;
    const float* s0;
    if (!samp) { const int seg = item >> 3, bh = item & 7; h = bh & 3; rbase = (bh >> 2) * SEQ + seg * (64 * GSEG); nch = GSEG; nrows = 64;
        s0 = GU + ((size_t)bh * 128 + seg * GSEG) * 8192; }
    else { const int si = item - NGLA_P; sb = si >> 2; h = si & 3; rbase = MP + sb * DECS; nch = 1; nrows = DECS;
        s0 = a->in[4] + (((size_t)l * DECB + sb) * 4 + h) * 8192; }
    f32x4 S[4];
#pragma unroll
    for (int j = 0; j < 4; ++j)
#pragma unroll
        for (int g = 0; g < 4; ++g) S[j][g] = s0[(d0 + g) * 128 + e0 + 16 * j];
    for (int c = 0; c < nch; ++c) {
        const int r0 = rbase + c * 64;
        gla_front(L, PROJ, r0, nrows, h, w2l, bl, tid);
        f32x4 u[4]; gla_U(L, wv, r, quad, u);
        { const int tt = td; const bf16x8 a0 = ldfrag(L, GB_QE + (16 * tt + r) * 144 + quad * 16), a1 = ldfrag(L, GB_QE + (16 * tt + r) * 144 + 64 + quad * 16);
#pragma unroll
          for (int jj = 0; jj < 2; ++jj) { const int ts = 2 * (wv & 1) + jj; f32x4 acc = {0.f, 0.f, 0.f, 0.f};
              if (ts <= tt) { const int ko = GB_KE + (16 * ts + r) * 144 + quad * 16;
                  acc = __builtin_amdgcn_mfma_f32_16x16x32_bf16(a0, ldfrag(L, ko), acc, 0, 0, 0);
                  acc = __builtin_amdgcn_mfma_f32_16x16x32_bf16(a1, ldfrag(L, ko + 64), acc, 0, 0, 0); }
              LAS unsigned short* at = (LAS unsigned short*)(L + GB_ATT) + (16 * tt + 4 * quad) * 72 + 16 * ts + r;
#pragma unroll
              for (int g = 0; g < 4; ++g) at[g * 72] = bf1((16 * ts + r <= 16 * tt + 4 * quad + g) ? acc[g] : 0.f); } }
#pragma unroll
        for (int j = 0; j < 4; ++j) { u32x2 w; w.x = pkbf(S[j][0], S[j][1]); w.y = pkbf(S[j][2], S[j][3]); *(LAS u32x2*)(L + GB_ST + (e0 + 16 * j) * 144 + d0 * 2) = w; }
        __syncthreads();
        f32x4 o[4];
        { const int ao = (16 * td + r) * 144 + quad * 16;
          const bf16x8 p0 = ldfrag(L, GB_ATT + ao), p1 = ldfrag(L, GB_ATT + ao + 64), q0 = ldfrag(L, GB_QE + ao), q1 = ldfrag(L, GB_QE + ao + 64);
#pragma unroll
          for (int j = 0; j < 4; ++j) { const int bo = (16 * (te0 + j) + r) * 144 + quad * 16; f32x4 acc = {0.f, 0.f, 0.f, 0.f};
              acc = __builtin_amdgcn_mfma_f32_16x16x32_bf16(p0, ldfrag(L, GB_VT + bo), acc, 0, 0, 0);
              acc = __builtin_amdgcn_mfma_f32_16x16x32_bf16(p1, ldfrag(L, GB_VT + bo + 64), acc, 0, 0, 0);
              acc = __builtin_amdgcn_mfma_f32_16x16x32_bf16(q0, ldfrag(L, GB_ST + bo), acc, 0, 0, 0);
              acc = __builtin_amdgcn_mfma_f32_16x16x32_bf16(q1, ldfrag(L, GB_ST + bo + 64), acc, 0, 0, 0);
              o[j] = acc; } }
        { LAS float* SSQ = (LAS float*)(L + GB_SSQ); f32x4 sp;
#pragma unroll
          for (int g = 0; g < 4; ++g) { float s = (o[0][g] * o[0][g] + o[1][g] * o[1][g]) + (o[2][g] * o[2][g] + o[3][g] * o[3][g]); s += shx<1>(s); s += shx<2>(s); s += shx<4>(s); s += shx<8>(s); sp[g] = s; }
          if (r == 0) {
#pragma unroll
              for (int g = 0; g < 4; ++g) SSQ[(d0 + g) * 2 + (wv & 1)] = sp[g]; }
          __syncthreads();
          unsigned short grv[4][4]; float gnv[4];
#pragma unroll
          for (int j = 0; j < 4; ++j) gnv[j] = gn[h * 128 + e0 + 16 * j];
#pragma unroll
          for (int g = 0; g < 4; ++g) { const int t = (d0 + g < nrows) ? d0 + g : 0; const bf16* grp = PROJ + (size_t)(r0 + t) * NIN + C_GR + h * 128 + e0;
#pragma unroll
              for (int j = 0; j < 4; ++j) grv[g][j] = grp[16 * j]; }
#pragma unroll
          for (int g = 0; g < 4; ++g) { const int t = d0 + g; const float rs = rsqrtf((SSQ[t * 2] + SSQ[t * 2 + 1]) * (1.f / 128.f) + EPS);
              if (t < nrows) { bf16* mp = MIX + (size_t)(r0 + t) * DM + 512 + h * 128 + e0;
#pragma unroll
                  for (int j = 0; j < 4; ++j) { const float gr = __uint_as_float(((unsigned)grv[g][j]) << 16); mp[16 * j] = bf1(o[j][g] * rs * gnv[j] * silu_f(gr)); } } } }
        { const f32x4 dv = *(const LAS f32x4*)(L + GB_DV + d0 * 4);
#pragma unroll
          for (int j = 0; j < 4; ++j) { S[j][0] = dv.x * S[j][0] + u[j][0]; S[j][1] = dv.y * S[j][1] + u[j][1]; S[j][2] = dv.z * S[j][2] + u[j][2]; S[j][3] = dv.w * S[j][3] + u[j][3]; } }
    }
    if (samp) { float* so = a->out + O_GS + (((size_t)l * DECB + sb) * 4 + h) * 8192;
#pragma unroll
        for (int j = 0; j < 4; ++j)
#pragma unroll
            for (int g = 0; g < 4; ++g) so[(d0 + g) * 128 + e0 + 16 * j] = S[j][g]; }
}
__device__ __forceinline__ void gla_scan_item(float* GU, const float* GD, float* outS  , int e) {
    {
        const int bh = e >> 13, el = e & 8191, d = el >> 7;
        float* up = GU + (size_t)bh * 128 * 8192 + el; const float* dp = GD + (size_t)bh * 128 * 64 + d;
        float s0 = 0.f, s1 = 0.f, s2 = 0.f, s3 = 0.f, p0 = 1.f, p1 = 1.f, p2 = 1.f;
#pragma unroll 4
        for (int c = 0; c < 32; ++c) {
            const float u0 = up[(size_t)c * 8192], u1 = up[(size_t)(32 + c) * 8192], u2 = up[(size_t)(64 + c) * 8192], u3 = up[(size_t)(96 + c) * 8192];
            const float d0 = dp[c * 64], d1 = dp[(32 + c) * 64], d2 = dp[(64 + c) * 64], d3 = dp[(96 + c) * 64];
            s0 = d0 * s0 + u0; s1 = d1 * s1 + u1; s2 = d2 * s2 + u2; s3 = d3 * s3 + u3; p0 *= d0; p1 *= d1; p2 *= d2; (void)d3; }
        float t0 = 0.f, t1 = s0, t2 = p1 * t1 + s1, t3 = p2 * t2 + s2; (void)p0; (void)s3;
        float uc[4][4], dc[4][4], un[4][4], dn[4][4];
#pragma unroll
        for (int k = 0; k < 4; ++k)
#pragma unroll
            for (int q = 0; q < 4; ++q) { uc[k][q] = up[(size_t)(32 * q + k) * 8192]; dc[k][q] = dp[(32 * q + k) * 64]; }
        for (int blk = 0; blk < 8; ++blk) {
            const int cn = (blk < 7 ? blk + 1 : blk) * 4;
#pragma unroll
            for (int k = 0; k < 4; ++k)
#pragma unroll
                for (int q = 0; q < 4; ++q) { un[k][q] = up[(size_t)(32 * q + cn + k) * 8192]; dn[k][q] = dp[(32 * q + cn + k) * 64]; }
#pragma unroll
            for (int k = 0; k < 4; ++k) { const int c = blk * 4 + k;
                up[(size_t)c * 8192] = t0; up[(size_t)(32 + c) * 8192] = t1; up[(size_t)(64 + c) * 8192] = t2; up[(size_t)(96 + c) * 8192] = t3;
                t0 = dc[k][0] * t0 + uc[k][0]; t1 = dc[k][1] * t1 + uc[k][1]; t2 = dc[k][2] * t2 + uc[k][2]; t3 = dc[k][3] * t3 + uc[k][3]; }
#pragma unroll
            for (int k = 0; k < 4; ++k)
#pragma unroll
                for (int q = 0; q < 4; ++q) { uc[k][q] = un[k][q]; dc[k][q] = dn[k][q]; }
        }
        outS[e] = t3;
    }
}

constexpr int CB_W = 0;
constexpr int CB_VT = 128 * 272;
static_assert(CB_VT + 128 * 272 <= SCR_BYTES, "cm lds");
__device__ __forceinline__ void cm_item(lbytes L, const bf16* PROJ, bf16* MIX, int item, int l, KArgs a, int tid) {
    int r0, g, nrows;
    if (item < 512) { g = item & 3; const int bn = item >> 2; r0 = (bn >> 6) * SEQ + (bn & 63) * 128; nrows = 128; }
    else { const int si = item - 512; g = si & 3; r0 = MP + (si >> 2) * DECS; nrows = DECS; }
    const float* Wg = a->in[8] + ((size_t)l * 4 + g) * 128 * 128; const float* bg = a->in[9] + ((size_t)l * 4 + g) * 128;
    __syncthreads();
    { const int j = tid >> 2, c0 = (tid & 3) * 32; float x[16], y[16];
      { const GAS f32x4* wp = (const GAS f32x4*)(Wg + (size_t)j * 128 + c0); LAS v4u* wd = (LAS v4u*)(L + CB_W + j * 272 + c0 * 2);
#pragma unroll
        for (int q = 0; q < 4; ++q) { const f32x4 w0 = wp[2 * q], w1 = wp[2 * q + 1]; v4u o; o.x = pkbf(w0.x, w0.y); o.y = pkbf(w0.z, w0.w); o.z = pkbf(w1.x, w1.y); o.w = pkbf(w1.z, w1.w); wd[q] = o; } }
      if (j < nrows) { const GAS v4u* p = (const GAS v4u*)(PROJ + (size_t)(r0 + j) * NIN + C_CV + g * 128 + c0); unpack16(p[0], p[1], x); unpack16(p[2], p[3], y); } else {
#pragma unroll
          for (int i = 0; i < 16; ++i) { x[i] = 0.f; y[i] = 0.f; } }
      float s = 0.f;
#pragma unroll
      for (int i = 0; i < 16; ++i) { x[i] = gelu_t(x[i]); y[i] = gelu_t(y[i]); s += x[i] + y[i]; }
      s += shx<1>(s); s += shx<2>(s);
      const float mu = s * (1.f / 128.f); float q = 0.f;
#pragma unroll
      for (int i = 0; i < 16; ++i) { x[i] -= mu; y[i] -= mu; q += x[i] * x[i] + y[i] * y[i]; }
      q += shx<1>(q); q += shx<2>(q);
      const float rs = (j < nrows) ? rsqrtf(q * (1.f / 128.f) + EPS) : 0.f;
#pragma unroll
      for (int i = 0; i < 16; ++i) { x[i] *= rs; y[i] *= rs; }
      LAS unsigned short* vt = (LAS unsigned short*)(L + CB_VT) + c0 * 136 + j;
#pragma unroll
      for (int i = 0; i < 16; ++i) { vt[i * 136] = bf1(x[i]); vt[(16 + i) * 136] = bf1(y[i]); }
      if (item >= 512 && j < nrows) { GAS f32x4* o4 = (GAS f32x4*)(a->out + O_CM + ((size_t)l * MS + (r0 - MP) + j) * 512 + g * 128 + c0);
#pragma unroll
          for (int i = 0; i < 4; ++i) { o4[i] = (f32x4){x[4 * i], x[4 * i + 1], x[4 * i + 2], x[4 * i + 3]}; o4[4 + i] = (f32x4){y[4 * i], y[4 * i + 1], y[4 * i + 2], y[4 * i + 3]}; } } }
    __syncthreads();
    const int wv = __builtin_amdgcn_readfirstlane(tid >> 6), lane = tid & 63, r = lane & 15, quad = lane >> 4;
#pragma unroll
    for (int half = 0; half < 2; ++half) {
        const int ti = half * 4 + (wv >> 1);
        if (16 * ti < nrows) {
            f32x4 acc[4];
#pragma unroll
            for (int jc = 0; jc < 4; ++jc) acc[jc] = (f32x4){0.f, 0.f, 0.f, 0.f};
#pragma unroll
            for (int k = 0; k < 4; ++k) { if (half == 0 && k >= 2) break;
                const bf16x8 af = ldfrag(L, CB_W + (16 * ti + r) * 272 + k * 64 + quad * 16);
#pragma unroll
                for (int jc = 0; jc < 4; ++jc) acc[jc] = __builtin_amdgcn_mfma_f32_16x16x32_bf16(af, ldfrag(L, CB_VT + (16 * (4 * (wv & 1) + jc) + r) * 272 + k * 64 + quad * 16), acc[jc], 0, 0, 0); }
            const int cc = g * 128 + 64 * (wv & 1) + r;
            unsigned short uv[4][4]; float bbv[4];
#pragma unroll
            for (int gq = 0; gq < 4; ++gq) { int ii = 16 * ti + 4 * quad + gq; if (ii >= nrows) ii = 0; bbv[gq] = bg[ii]; const bf16* up = PROJ + (size_t)(r0 + ii) * NIN + C_CU + cc;
#pragma unroll
                for (int jc = 0; jc < 4; ++jc) uv[gq][jc] = up[16 * jc]; }
#pragma unroll
            for (int gq = 0; gq < 4; ++gq) { const int ii = 16 * ti + 4 * quad + gq;
                if (ii < nrows) { bf16* mp = MIX + (size_t)(r0 + ii) * DM + cc;
#pragma unroll
                    for (int jc = 0; jc < 4; ++jc) { const float uu = __uint_as_float(((unsigned)uv[gq][jc]) << 16); mp[16 * jc] = bf1(gelu_t(uu) * (acc[jc][gq] + bbv[gq])); } } }
        }
    }
}

constexpr int SA_Q = 0, SA_K = 16 * 128, SA_V = SA_K + 64 * 132, SA_A = SA_V + 64 * 132;
static_assert((SA_A + 16 * 64 + 8) * 4 <= SCR_BYTES, "sa lds");
__device__ __forceinline__ float sfx32(float x, int j, int lane) {
#pragma unroll
    for (int o = 1; o < 32; o <<= 1) { const float y = bperm(x, lane + o); x *= (j + o < 32) ? y : 1.f; }
    return x;
}
__device__ __forceinline__ void sattn_item(LAS float* L, const bf16* PROJ, bf16* MIX, int item, int l, KArgs a, int tid) {
    const int sb = item >> 3, h = item & 7, rq = MP + sb * DECS;
    const int i = tid >> 5, j = tid & 31;
    __syncthreads();
    { const int qi = tid >> 5, d4 = (tid & 31) * 4; const u32x2 w = *(const GAS u32x2*)(PROJ + (size_t)(rq + qi) * NIN + C_SQ + h * 128 + d4);
      f32x4 x = {bf_lo(w.x), bf_hi(w.x), bf_lo(w.y), bf_hi(w.y)}; float ss = (x.x * x.x + x.y * x.y) + (x.z * x.z + x.w * x.w);
      ss += shx<1>(ss); ss += shx<2>(ss); ss += shx<4>(ss); ss += shx<8>(ss); ss += shx<16>(ss);
      const f32x4 gg = *(const GAS f32x4*)(a->in[13] + (size_t)l * 128 + d4);
      *(LAS f32x4*)(L + SA_Q + qi * 128 + d4) = x * (rsqrtf(ss * (1.f / 128.f) + EPS) * QSCALE) * gg; }
    f32x4 o = {0.f, 0.f, 0.f, 0.f}; float carry = 1.f;
    const float* ck = a->in[2] + ((size_t)l * DECB + sb) * PAST * 1024 + h * 128; const float* cv = a->in[3] + ((size_t)l * DECB + sb) * PAST * 1024 + h * 128;
    for (int blk = 32; blk >= 0; --blk) {
        __syncthreads();
        { const int key = tid >> 3, c = tid & 7;
          if (blk == 32) {
              float kx[16], vx[16];
              if (key < DECS) { const bf16* prow = PROJ + (size_t)(rq + key) * NIN + h * 128 + c * 16; const GAS v4u* pk = (const GAS v4u*)(prow + C_SK); const GAS v4u* pv = (const GAS v4u*)(prow + C_SV);
                  unpack16(pk[0], pk[1], kx); unpack16(pv[0], pv[1], vx); } else {
#pragma unroll
                  for (int t = 0; t < 16; ++t) { kx[t] = 0.f; vx[t] = 0.f; } }
              { float ss = 0.f;
#pragma unroll
                for (int t = 0; t < 16; ++t) ss += kx[t] * kx[t];
                ss += shx<1>(ss); ss += shx<2>(ss); ss += shx<4>(ss);
                const float rs = rsqrtf(ss * (1.f / 128.f) + EPS); const GAS f32x4* g4 = (const GAS f32x4*)(a->in[14] + (size_t)l * 128 + c * 16);
#pragma unroll
                for (int t = 0; t < 4; ++t) { const f32x4 gg = g4[t]; kx[4 * t] *= rs * gg.x; kx[4 * t + 1] *= rs * gg.y; kx[4 * t + 2] *= rs * gg.z; kx[4 * t + 3] *= rs * gg.w; }
                if (key < DECS) { GAS f32x4* o4 = (GAS f32x4*)(a->out + O_KS + ((size_t)l * MS + sb * DECS + key) * 1024 + h * 128 + c * 16);
#pragma unroll
                    for (int t = 0; t < 4; ++t) o4[t] = (f32x4){kx[4 * t], kx[4 * t + 1], kx[4 * t + 2], kx[4 * t + 3]}; } }
              LAS f32x4* dk = (LAS f32x4*)(L + SA_K + key * 132 + c * 16); LAS f32x4* dv = (LAS f32x4*)(L + SA_V + key * 132 + c * 16);
#pragma unroll
              for (int t = 0; t < 4; ++t) { dk[t] = (f32x4){kx[4 * t], kx[4 * t + 1], kx[4 * t + 2], kx[4 * t + 3]}; dv[t] = (f32x4){vx[4 * t], vx[4 * t + 1], vx[4 * t + 2], vx[4 * t + 3]}; }
          } else {
              const size_t off = (size_t)(blk * 64 + key) * 1024;
#pragma unroll
              for (int t = 0; t < 4; ++t) { const int d = t * 32 + c * 4;
                  *(LAS f32x4*)(L + SA_K + key * 132 + d) = *(const GAS f32x4*)(ck + off + d); *(LAS f32x4*)(L + SA_V + key * 132 + d) = *(const GAS f32x4*)(cv + off + d); }
          } }
        __syncthreads();
        float zl = 0.f, zh = 0.f;
        { const LAS f32x4* q4 = (const LAS f32x4*)(L + SA_Q + i * 128); const LAS f32x4* kl = (const LAS f32x4*)(L + SA_K + j * 132); const LAS f32x4* kh = (const LAS f32x4*)(L + SA_K + (j + 32) * 132);
#pragma unroll 8
          for (int d = 0; d < 32; ++d) { const f32x4 q = q4[d], x = kl[d], y = kh[d]; zl += (q.x * x.x + q.y * x.y) + (q.z * x.z + q.w * x.w); zh += (q.x * y.x + q.y * y.y) + (q.z * y.z + q.w * y.w); } }
        const bool vl = (blk < 32) || (j < i), vh = (blk < 32);
        const float el = __builtin_amdgcn_exp2f(zl), eh = __builtin_amdgcn_exp2f(zh), rl = __builtin_amdgcn_rcpf(1.f + el), rh = __builtin_amdgcn_rcpf(1.f + eh);
        const float stl = vl ? rl : 1.f, sth = vh ? rh : 1.f, bl_ = vl ? el * rl : 0.f, bh_ = vh ? eh * rh : 0.f;
        const int lane = tid & 63; const float xh = sfx32(sth, j, lane), xl = sfx32(stl, j, lane);
        float eh_x = bperm(xh, lane + 1); eh_x = (j < 31) ? eh_x : 1.f;
        float el_x = bperm(xl, lane + 1); el_x = (j < 31) ? el_x : 1.f;
        const float totH = bperm(xh, lane & 32), totL = bperm(xl, lane & 32);
        L[SA_A + i * 64 + 32 + j] = bh_ * eh_x * carry;
        L[SA_A + i * 64 + j] = bl_ * el_x * totH * carry;
        carry = carry * totH * totL;
        if ((tid & 63) == 0) L[SA_A + 1024 + (tid >> 6)] = __all(carry == 0.f) ? 1.f : 0.f;
        __syncthreads();
        { const int d4 = j * 4; const LAS float* ap = L + SA_A + i * 64;
#pragma unroll 8
          for (int s = 0; s < 64; ++s) { const float p = ap[s]; const f32x4 v4 = *(const LAS f32x4*)(L + SA_V + s * 132 + d4); o += p * v4; } }
        { const f32x4 f0 = *(const LAS f32x4*)(L + SA_A + 1024), f1 = *(const LAS f32x4*)(L + SA_A + 1028); if ((f0.x * f0.y) * (f0.z * f0.w) * (f1.x * f1.y) * (f1.z * f1.w) != 0.f) break; }
    }
    { u32x2 w; w.x = pkbf(o.x, o.y); w.y = pkbf(o.z, o.w); *(GAS u32x2*)(MIX + (size_t)(rq + i) * DM + 1024 + h * 128 + j * 4) = w; }
}

namespace att {
typedef short s16x4 __attribute__((ext_vector_type(4)));
typedef float f32x16 __attribute__((ext_vector_type(16)));
constexpr int SHM_V = 64 * 128 * 2, SHM_K = 64 * 128 * 2;
#define KSWZ(row, colB) ((row) * 256 + ((colB) ^ (((row) & 7) << 4)))
#define SBAR() __builtin_amdgcn_sched_barrier(0)
__device__ __forceinline__ int v_st(int k, int c) { const int kk = (k & ~0xC) | ((k & 4) << 1) | ((k & 8) >> 1); return ((kk >> 3) * 4 + (c >> 5)) * 512 + ((kk & 7) * 32 + (c & 31)) * 2; }
__device__ __forceinline__ int v_rd_base(int lane) { return ((lane & 3) << 3) | (((lane >> 2) & 3) << 6) | (((lane >> 4) & 1) << 5) | (((lane >> 5) & 1) << 8); }
constexpr int v_rd_off(int d0, int ks, int half) { return d0 * 512 + ks * 4096 + half * 2048; }
__device__ __forceinline__ int crow(int r, int hi) { return (r & 3) + 8 * (r >> 2) + 4 * hi; }
__device__ __forceinline__ void qkt(f32x16& p0, f32x16& p1, const char* K_lds, int r32, int hi, const bf16x8* qr) {
    p0 = f32x16{}; p1 = f32x16{};
    const char* kb[4];
#pragma unroll
    for (int dd = 0; dd < 4; ++dd) kb[dd] = K_lds + KSWZ(r32, (dd * 16 + hi * 8) * 2);
#pragma unroll
    for (int d0 = 0; d0 < 8; ++d0) { const char* a = kb[d0 & 3] + (d0 >> 2) * 128;
        bf16x8 b0 = *reinterpret_cast<const bf16x8*>(a);
        bf16x8 b1 = *reinterpret_cast<const bf16x8*>(a + 32 * 256);
        p0 = __builtin_amdgcn_mfma_f32_32x32x16_bf16(b0, qr[d0], p0, 0, 0, 0);
        p1 = __builtin_amdgcn_mfma_f32_32x32x16_bf16(b1, qr[d0], p1, 0, 0, 0); }
}
__device__ __forceinline__ void pv_tile(f32x16* o, int vb0, bf16x8 pa0, bf16x8 pa1, bf16x8 pa2, bf16x8 pa3) {
#define TRRD(dst, off) asm volatile("ds_read_b64_tr_b16 %0, %1 offset:%2" : "=&v"(dst) : "v"(vb0), "i"(off) : "memory")
#define PV_D0(d0) do { s16x4 l0, l1, l2, l3, h0, h1, h2, h3; constexpr int b_ = v_rd_off(d0, 0, 0); \
        TRRD(l0, b_); TRRD(h0, b_ + 2048); TRRD(l1, b_ + 4096); TRRD(h1, b_ + 6144); TRRD(l2, b_ + 8192); TRRD(h2, b_ + 10240); TRRD(l3, b_ + 12288); TRRD(h3, b_ + 14336); \
        asm volatile("s_waitcnt lgkmcnt(0)" ::: "memory"); SBAR(); \
        o[d0] = __builtin_amdgcn_mfma_f32_32x32x16_bf16(pa0, (bf16x8){l0[0], l0[1], l0[2], l0[3], h0[0], h0[1], h0[2], h0[3]}, o[d0], 0, 0, 0); \
        o[d0] = __builtin_amdgcn_mfma_f32_32x32x16_bf16(pa1, (bf16x8){l1[0], l1[1], l1[2], l1[3], h1[0], h1[1], h1[2], h1[3]}, o[d0], 0, 0, 0); \
        o[d0] = __builtin_amdgcn_mfma_f32_32x32x16_bf16(pa2, (bf16x8){l2[0], l2[1], l2[2], l2[3], h2[0], h2[1], h2[2], h2[3]}, o[d0], 0, 0, 0); \
        o[d0] = __builtin_amdgcn_mfma_f32_32x32x16_bf16(pa3, (bf16x8){l3[0], l3[1], l3[2], l3[3], h3[0], h3[1], h3[2], h3[3]}, o[d0], 0, 0, 0); } while (0)
    PV_D0(0); PV_D0(1); PV_D0(2); PV_D0(3);
#undef PV_D0
#undef TRRD
}
template <bool MASK>
__device__ __forceinline__ void sb_tile(f32x16& p0, f32x16& p1, float& carry, int hi, int dq  ) {
#pragma unroll
    for (int r = 0; r < 16; ++r) { const int c = (r & 3) + 8 * (r >> 2);
        { const float e = __builtin_amdgcn_exp2f(p0[r]); p0[r] = (!MASK || (c < dq)) ? e : 0.f; }
        { const float e = __builtin_amdgcn_exp2f(p1[r]); p1[r] = (!MASK || (c + 32 < dq)) ? e : 0.f; } }
    float pp[8], pt[8], rk[8];
#pragma unroll
    for (int k = 0; k < 4; ++k) {
        { const float g = ((1.f + p0[4 * k]) * (1.f + p0[4 * k + 1])) * ((1.f + p0[4 * k + 2]) * (1.f + p0[4 * k + 3])); const float rg = __builtin_amdgcn_rcpf(g); rk[k] = rg;
          auto rr = __builtin_amdgcn_permlane32_swap(__float_as_uint(rg), __float_as_uint(rg), false, false);
          const float r0 = __uint_as_float(rr[0]), r1 = __uint_as_float(rr[1]); pp[k] = r0 * r1; pt[k] = hi ? 1.f : r1; }
        { const float g = ((1.f + p1[4 * k]) * (1.f + p1[4 * k + 1])) * ((1.f + p1[4 * k + 2]) * (1.f + p1[4 * k + 3])); const float rg = __builtin_amdgcn_rcpf(g); rk[4 + k] = rg;
          auto rr = __builtin_amdgcn_permlane32_swap(__float_as_uint(rg), __float_as_uint(rg), false, false);
          const float r0 = __uint_as_float(rr[0]), r1 = __uint_as_float(rr[1]); pp[4 + k] = r0 * r1; pt[4 + k] = hi ? 1.f : r1; } }
    float pe = carry; float one = 1.f; asm volatile("" : "+v"(one));
#pragma unroll
    for (int k = 7; k >= 0; --k) { const float x = pe * pt[k]; pe *= pp[k];
        if (k >= 4) { const int b = 4 * (k - 4); const float i0 = x * rk[k], i1 = i0 * (one + p1[b]), i2 = i1 * (one + p1[b + 1]), i3 = i2 * (one + p1[b + 2]);
            p1[b] *= i0; p1[b + 1] *= i1; p1[b + 2] *= i2; p1[b + 3] *= i3; }
        else { const int b = 4 * k; const float i0 = x * rk[k], i1 = i0 * (one + p0[b]), i2 = i1 * (one + p0[b + 1]), i3 = i2 * (one + p0[b + 2]);
            p0[b] *= i0; p0[b + 1] *= i1; p0[b + 2] *= i2; p0[b + 3] *= i3; } }
    carry = pe;
}
#define PK4(P, B_, OUT) do { unsigned a0 = pkbf(P[B_ + 0], P[B_ + 1]), a1 = pkbf(P[B_ + 2], P[B_ + 3]); \
        unsigned b0 = pkbf(P[B_ + 4], P[B_ + 5]), b1 = pkbf(P[B_ + 6], P[B_ + 7]); \
        auto r0 = __builtin_amdgcn_permlane32_swap(a0, b0, false, false); auto r1 = __builtin_amdgcn_permlane32_swap(a1, b1, false, false); \
        v4u w = {r0[0], r1[0], r0[1], r1[1]}; OUT = *reinterpret_cast<bf16x8*>(&w); } while (0)

__device__ __forceinline__ void attn_item(char* lds, const bf16* PROJ, bf16* MIX, int b, int h, int qb, int tid, const float* __restrict__ gq, const float* __restrict__ gk, float* kout  ) {
    const int wid = __builtin_amdgcn_readfirstlane(tid >> 6), lane = tid & 63, r32 = lane & 31, hi = lane >> 5;
    char* V_lds = lds; char* K_lds = lds + 2 * SHM_V;
    const int P0 = qb * 256, rowbase = b * SEQ, qlo = P0 + wid * 32, qpos = qlo + r32;
    bf16x8 qr[8];
    { const bf16* qp = PROJ + (size_t)(rowbase + qpos) * NIN + C_SQ + h * 128 + hi * 8;
      v4u raw[8]; float ss = 0.f;
#pragma unroll
      for (int d0 = 0; d0 < 8; ++d0) raw[d0] = *reinterpret_cast<const v4u*>(qp + d0 * 16);
#pragma unroll
      for (int d0 = 0; d0 < 8; ++d0) { float x[8]; unpack8(raw[d0], x);
#pragma unroll
          for (int i = 0; i < 8; ++i) ss += x[i] * x[i]; }
      ss = sum_x32(ss);
      const float rs = rsqrtf(ss * (1.f / 128.f) + EPS) * QSCALE;
#pragma unroll
      for (int d0 = 0; d0 < 8; ++d0) { float x[8]; unpack8(raw[d0], x); const f32x4 g0 = *(const GAS f32x4*)(gq + d0 * 16 + hi * 8), g1 = *(const GAS f32x4*)(gq + d0 * 16 + hi * 8 + 4);
          x[0] *= rs * g0.x; x[1] *= rs * g0.y; x[2] *= rs * g0.z; x[3] *= rs * g0.w; x[4] *= rs * g1.x; x[5] *= rs * g1.y; x[6] *= rs * g1.z; x[7] *= rs * g1.w;
          const v4u w = pack8f(x); qr[d0] = *reinterpret_cast<const bf16x8*>(&w); } }
    f32x16 o[4] = {};
    float carry = 1.f;
    const int sr = tid >> 4, sc = (tid & 15) * 8, vst0 = v_st(sr, sc), vst1 = v_st(32 + sr, sc), kws = KSWZ(sr, sc * 2);
    const int vb0 = (int)(uintptr_t)V_lds + v_rd_base(lane);
    volatile LAS int* dn = (volatile LAS int*)(lds + 2 * SHM_V + 2 * SHM_K);
    bool wdone = false;
    const bf16* kvp = PROJ + (size_t)(rowbase + sr) * NIN + C_SK + h * 128 + sc;
    bf16x8 sk0, sk1, sv0, sv1;
    { const bf16* kp = kvp + (size_t)((4 * qb + 3) * 64) * NIN;
      sk0 = *reinterpret_cast<const bf16x8*>(kp); sk1 = *reinterpret_cast<const bf16x8*>(kp + (size_t)32 * NIN);
      sv0 = *reinterpret_cast<const bf16x8*>(kp + (C_SV - C_SK)); sv1 = *reinterpret_cast<const bf16x8*>(kp + (size_t)32 * NIN + (C_SV - C_SK)); }
    for (int jt = 4 * qb + 3; jt >= 0; --jt) {
        const int kb0 = jt * 64, bo = (jt & 1) * SHM_K;
        {
          float gk8[8]; { const f32x4 g0 = *(const GAS f32x4*)(gk + (tid & 15) * 8), g1 = *(const GAS f32x4*)(gk + (tid & 15) * 8 + 4); gk8[0] = g0.x; gk8[1] = g0.y; gk8[2] = g0.z; gk8[3] = g0.w; gk8[4] = g1.x; gk8[5] = g1.y; gk8[6] = g1.z; gk8[7] = g1.w; }
          float x0[8], x1[8]; unpack8(*reinterpret_cast<const v4u*>(&sk0), x0); unpack8(*reinterpret_cast<const v4u*>(&sk1), x1); float s0 = 0.f, s1 = 0.f;
#pragma unroll
          for (int i = 0; i < 8; ++i) { s0 += x0[i] * x0[i]; s1 += x1[i] * x1[i]; }
          s0 += shx<1>(s0); s0 += shx<2>(s0); s0 += shx<4>(s0); s0 += shx<8>(s0); s1 += shx<1>(s1); s1 += shx<2>(s1); s1 += shx<4>(s1); s1 += shx<8>(s1);
          const float r0 = rsqrtf(s0 * (1.f / 128.f) + EPS), r1 = rsqrtf(s1 * (1.f / 128.f) + EPS);
#pragma unroll
          for (int i = 0; i < 8; ++i) { x0[i] *= r0 * gk8[i]; x1[i] *= r1 * gk8[i]; }
          const v4u w0 = pack8f(x0), w1 = pack8f(x1);
          *(v4u*)(K_lds + bo + kws) = w0; *(v4u*)(K_lds + bo + kws + 32 * 256) = w1; *(bf16x8*)(V_lds + bo + vst0) = sv0; *(bf16x8*)(V_lds + bo + vst1) = sv1;
          if (jt > 0) { const bf16* kp = kvp + (size_t)(kb0 - 64) * NIN;
            sk0 = *reinterpret_cast<const bf16x8*>(kp); sk1 = *reinterpret_cast<const bf16x8*>(kp + (size_t)32 * NIN);
            sv0 = *reinterpret_cast<const bf16x8*>(kp + (C_SV - C_SK)); sv1 = *reinterpret_cast<const bf16x8*>(kp + (size_t)32 * NIN + (C_SV - C_SK)); }
          if (jt >= 4 * qb) { float* kp0 = kout + (size_t)(rowbase + kb0 + sr) * 1024 + h * 128 + sc;
              __builtin_nontemporal_store((f32x4){x0[0], x0[1], x0[2], x0[3]}, (f32x4*)kp0); __builtin_nontemporal_store((f32x4){x0[4], x0[5], x0[6], x0[7]}, (f32x4*)(kp0 + 4));
              __builtin_nontemporal_store((f32x4){x1[0], x1[1], x1[2], x1[3]}, (f32x4*)(kp0 + 32 * 1024)); __builtin_nontemporal_store((f32x4){x1[4], x1[5], x1[6], x1[7]}, (f32x4*)(kp0 + 32 * 1024 + 4)); } }
        volatile LAS int* dj = dn + (jt & 1) * 8;
        if (lane == 0) dj[wid] = wdone ? 1 : 0;
        __syncthreads();
        { const int a0 = dj[0] & dj[1] & dj[2] & dj[3], a1 = dj[4] & dj[5] & dj[6] & dj[7]; if (a0 & a1) break; }
        if (kb0 < qlo + 31 && !wdone) {
            f32x16 p0, p1;
            qkt(p0, p1, K_lds + bo, r32, hi, qr);
            if (kb0 + 63 >= qlo) sb_tile<true>(p0, p1, carry, hi, qpos - kb0 - 4 * hi); else sb_tile<false>(p0, p1, carry, hi, 0);
            bf16x8 pa0, pa1, pa2, pa3;
            PK4(p0, 0, pa0); PK4(p0, 8, pa1); PK4(p1, 0, pa2); PK4(p1, 8, pa3);
            pv_tile(o, vb0 + bo, pa0, pa1, pa2, pa3);
            wdone = __all(carry == 0.f) != 0;
        }
    }
    bf16* Ow = MIX + (size_t)(rowbase + qlo) * DM + 1024 + h * 128;
#pragma unroll
    for (int r = 0; r < 16; ++r) { const int orow = crow(r, hi);
#pragma unroll
        for (int d0 = 0; d0 < 4; ++d0) { const float v = o[d0][r]; const float vn = shx<1>(v);
            if ((r32 & 1) == 0) *(unsigned*)(Ow + (size_t)orow * DM + d0 * 32 + r32) = pkbf(v, vn); } }
}
#undef PK4
#undef KSWZ
#undef SBAR
}

__device__ __forceinline__ void conv_fix_phase(const float* GH, const float* SBR, bf16* HID, const float* PGU, const float* SS2, int l, KArgs a, int gtid, int GT) {
    const float* cw = a->in[19] + (size_t)l * 3 * FF; const float* cb = a->in[20] + (size_t)l * FF;
    constexpr int NF4 = FF / 4;
    for (int idx = gtid; idx < MS * NF4; idx += GT) {
        const int rs = idx / NF4, f = (idx - rs * NF4) * 4, i = rs & 15, sb = rs >> 4, col = (f >> 7) * 256 + (f & 127);
        f32x4 g2 = {0.f, 0.f, 0.f, 0.f}, g1 = g2, g0 = g2, uu = g2;
#pragma unroll
        for (int p = 0; p < NP_GU; ++p) { const float* pp = PGU + ((size_t)p * 128 + rs) * NGU + col;
            g2 += *(const GAS f32x4*)pp; uu += *(const GAS f32x4*)(pp + 128);
            if (i >= 1) g1 += *(const GAS f32x4*)(pp - NGU); if (i >= 2) g0 += *(const GAS f32x4*)(pp - 2 * NGU); }
        const float r2 = rsqrtf(SS2[MP + rs] * (1.f / DM) + EPS); g2 *= r2; uu *= r2;
        const float* st = a->in[5] + ((size_t)l * DECB + sb) * 2 * FF + f;
        if (i >= 1) g1 *= rsqrtf(SS2[MP + rs - 1] * (1.f / DM) + EPS); else g1 = *(const GAS f32x4*)(st + FF);
        if (i >= 2) g0 *= rsqrtf(SS2[MP + rs - 2] * (1.f / DM) + EPS); else g0 = *(const GAS f32x4*)(st + (i == 0 ? 0 : FF));
        const f32x4 w0 = *(const GAS f32x4*)(cw + f), w1 = *(const GAS f32x4*)(cw + FF + f), w2 = *(const GAS f32x4*)(cw + 2 * FF + f), bb = *(const GAS f32x4*)(cb + f);
        const f32x4 gg = bb + w0 * g0 + w1 * g1 + w2 * g2;
        u32x2 w; w.x = pkbf(silu_f(gg.x) * uu.x, silu_f(gg.y) * uu.y); w.y = pkbf(silu_f(gg.z) * uu.z, silu_f(gg.w) * uu.w);
        *(GAS u32x2*)(HID + (size_t)(MP + rs) * FF + f) = w;
        if (i >= 14) *(GAS f32x4*)(a->out + O_CS + (((size_t)l * DECB + sb) * 2 + (i - 14)) * FF + f) = g2;
    }
#define CF_LOAD(S_, idx_) \
        const int k##S_ = (idx_) / NF4, f##S_ = ((idx_) - k##S_ * NF4) * 4; const float* sb##S_ = SBR + ((size_t)(k##S_ * 2) * 2) * FF + f##S_; \
        const f32x4 ga##S_ = *(const GAS f32x4*)(sb##S_), ua##S_ = *(const GAS f32x4*)(sb##S_ + FF), gb##S_ = *(const GAS f32x4*)(sb##S_ + 2 * FF), ub##S_ = *(const GAS f32x4*)(sb##S_ + 3 * FF); \
        f32x4 h1##S_ = {0.f, 0.f, 0.f, 0.f}, h0##S_ = {0.f, 0.f, 0.f, 0.f}; \
        if ((k##S_ & 127) != 0) { h1##S_ = *(const GAS f32x4*)(GH + ((size_t)(k##S_ - 1) * 2 + 1) * FF + f##S_); h0##S_ = *(const GAS f32x4*)(GH + ((size_t)(k##S_ - 1) * 2) * FF + f##S_); } \
        const f32x4 w0##S_ = *(const GAS f32x4*)(cw + f##S_), w1##S_ = *(const GAS f32x4*)(cw + FF + f##S_), w2##S_ = *(const GAS f32x4*)(cw + 2 * FF + f##S_), bb##S_ = *(const GAS f32x4*)(cb + f##S_)
#define CF_EMIT(S_) do { \
        const f32x4 xa = bb##S_ + w0##S_ * h0##S_ + w1##S_ * h1##S_ + w2##S_ * ga##S_, xb = bb##S_ + w0##S_ * h1##S_ + w1##S_ * ga##S_ + w2##S_ * gb##S_; \
        u32x2 wa, wb; wa.x = pkbf(silu_f(xa.x) * ua##S_.x, silu_f(xa.y) * ua##S_.y); wa.y = pkbf(silu_f(xa.z) * ua##S_.z, silu_f(xa.w) * ua##S_.w); \
        wb.x = pkbf(silu_f(xb.x) * ub##S_.x, silu_f(xb.y) * ub##S_.y); wb.y = pkbf(silu_f(xb.z) * ub##S_.z, silu_f(xb.w) * ub##S_.w); \
        *(GAS u32x2*)(HID + (size_t)(64 * k##S_) * FF + f##S_) = wa; *(GAS u32x2*)(HID + (size_t)(64 * k##S_ + 1) * FF + f##S_) = wb; } while (0)
    for (int idx = gtid; idx < 256 * NF4; idx += 2 * GT) {
        const int idx2 = idx + GT;
        if (idx2 < 256 * NF4) { CF_LOAD(A, idx); CF_LOAD(B, idx2); CF_EMIT(A); CF_EMIT(B); }
        else { CF_LOAD(A, idx); CF_EMIT(A); }
    }
#undef CF_LOAD
#undef CF_EMIT
}

#define PH_IDS() const int tid = fresh_tid(), lane = tid & 63, wave = __builtin_amdgcn_readfirstlane(tid >> 6); const int bx = fresh_bx(), G = gridDim.x; \
    const int vcu = (G % 8 == 0) ? (bx % 8) * (G / 8) + bx / 8 : bx; const int gw = vcu * NWAVES + wave, NGW = G * NWAVES, gtid = bx * NTHR + tid, GT = G * NTHR; \
    KArgs a = kargs(); unsigned char* ws = a->ws; (void)lane; (void)gw; (void)NGW; (void)gtid; (void)GT; (void)ws
#define GRID_BAR() do { KArgs a_ = kargs(); XcdBarrier b_; b_.bar = (unsigned*)(a_->ws + WS_CTL) + CW_BAR; b_.x = xb_xcc_id(); b_.st = (volatile LAS unsigned*)(lds + LCTL_OFF) + 8; xcd_barrier(b_); } while (0)
#ifdef PROBE_SEL
#define PROBE_T0() do { if (blockIdx.x == 0 && threadIdx.x == 0) { volatile LAS unsigned* LC_ = (volatile LAS unsigned*)(lds + LCTL_OFF); LC_[15] = (unsigned)__builtin_amdgcn_s_memrealtime(); } } while (0)
#define PROBE_ACC(k) do { if (blockIdx.x == 0 && threadIdx.x == 0) { volatile LAS unsigned* LC_ = (volatile LAS unsigned*)(lds + LCTL_OFF); const unsigned n_ = (unsigned)__builtin_amdgcn_s_memrealtime(); LC_[16 + (k)] += n_ - LC_[15]; LC_[15] = n_; } } while (0)
#define PROBE_IT0() do { if (blockIdx.x == 0 && threadIdx.x == 0) { volatile LAS unsigned* LC_ = (volatile LAS unsigned*)(lds + LCTL_OFF); LC_[12] = (unsigned)__builtin_amdgcn_s_memrealtime(); } } while (0)
#define PROBE_IT1(k) do { __syncthreads(); if (blockIdx.x == 0 && threadIdx.x == 0) { volatile LAS unsigned* LC_ = (volatile LAS unsigned*)(lds + LCTL_OFF); LC_[40 + (k)] += (unsigned)__builtin_amdgcn_s_memrealtime() - LC_[12]; } } while (0)
#define PROBE_KIND(k) do { if (threadIdx.x == 0) { volatile LAS unsigned* LC_ = (volatile LAS unsigned*)(lds + LCTL_OFF); LC_[14] = (k); } __syncthreads(); } while (0)
#else
#define PROBE_T0() do {} while (0)
#define PROBE_KIND(k) do {} while (0)
#define PROBE_IT0() do {} while (0)
#define PROBE_IT1(k) do {} while (0)
#define PROBE_ACC(k) do {} while (0)
#endif
__global__ void __launch_bounds__(NTHR, 2) fwd(Args a_unused) {
    extern __shared__ __attribute__((aligned(16))) unsigned char lds_raw[];
    LAS unsigned char* lds = (LAS unsigned char*)lds_raw;
    { volatile LAS unsigned* LC = (volatile LAS unsigned*)(lds + LCTL_OFF);
      if (threadIdx.x < 64) LC[threadIdx.x] = 0u;
      __syncthreads();
      KArgs a = kargs();
      (void)xcd_barrier_post((unsigned*)(a->ws + WS_CTL) + CW_BAR, LC + 8); }

    PROBE_T0();
    { PH_IDS(); asm volatile("; MARK_PHASE_1" ::: "memory"); p0_prologue(a, lds, gw, NGW, wave, lane, gtid, GT); }
    GRID_BAR(); PROBE_ACC(0);

    for (int l = 0; l < NL; ++l) {
        if (l) { { PH_IDS(); asm volatile("; MARK_PHASE_2" ::: "memory"); sample_rows_phase(a->out, (bf16*)(ws + WS_H), (float*)(ws + WS_SS1), (const float*)(ws + WS_SSP), (const float*)(ws + WS_PART), NP_DN, lds, bx, G, tid); }
                 GRID_BAR(); PROBE_ACC(1); }
        { PH_IDS(); asm volatile("; MARK_PHASE_3" ::: "memory"); pg8::Gemm g{(const bf16*)(ws + WS_H), (const bf16*)(ws + WS_W + (size_t)l * SZ_WL), MT, NIN, DM}; pg8::StaticOrder S; S.init(MT, NIN, G, bx, WGM_IN);
          pg8::EpiBf16RS E{(bf16*)(ws + WS_PROJ), NIN, (const float*)(ws + WS_SS1), 1.f / DM, EPS, a->out + O_VP + (size_t)l * MP * 1024, a->out + O_VS + (size_t)l * MS * 1024, C_SV / 256, MP, MR};
          PROBE_KIND(0); pg8::gemm_phase<pg8::EpiBf16RS, pg8::StaticOrder, true, true>(lds, g, S, E); }
        GRID_BAR(); PROBE_ACC(2);
        { PH_IDS(); asm volatile("; MARK_PHASE_4" ::: "memory"); bf16* PROJ = (bf16*)(ws + WS_PROJ);
          { const float* w2l = a->in[10] + (size_t)l * 16 * 256; const float* bl = a->in[11] + (size_t)l * 256;
            for (int it = bx; it < 1024; it += G) gla_prep_item(lds, PROJ, it, w2l, bl, (float*)(ws + WS_GLAU), (float*)(ws + WS_GLAD), ws + WS_GLAF, fresh_tid()); } }
        GRID_BAR(); PROBE_ACC(3);
        { PH_IDS(); asm volatile("; MARK_PHASE_5" ::: "memory"); bf16* PROJ = (bf16*)(ws + WS_PROJ); bf16* MIX = (bf16*)(ws + WS_MIX);
          volatile LAS unsigned* LC = (volatile LAS unsigned*)(lds + LCTL_OFF);
          unsigned* qctr = (unsigned*)(ws + WS_CTL) + CW_Q + 64 * l;
          constexpr int QS = 128, Q1 = QS + 512, Q2 = Q1 + 64, Q2b = Q2 + 544, Q3 = Q2b + 1024 + 32;
          unsigned* scnt = (unsigned*)(ws + WS_CTL) + CW_Q + 64 * (16 + l);
          if (tid == 0) LC[3] = 0u;
          unsigned nxt = 0u; if (tid == 0) nxt = __hip_atomic_fetch_add(qctr, 1u, __ATOMIC_RELAXED, __HIP_MEMORY_SCOPE_AGENT);
          for (;;) {
              __syncthreads();
              if (tid == 0) LC[0] = nxt;
              __syncthreads();
              const int it = (int)LC[0];
              if (it >= Q3) break;
              if (tid == 0) nxt = __hip_atomic_fetch_add(qctr, 1u, __ATOMIC_RELAXED, __HIP_MEMORY_SCOPE_AGENT);
              PROBE_IT0();
              if (it < QS) { asm volatile("; MARK_ITEM_SCAN" ::: "memory");
                  gla_scan_item((float*)(ws + WS_GLAU), (const float*)(ws + WS_GLAD), a->out + O_GP + (size_t)l * 8 * 8192, it * NTHR + fresh_tid());
                  asm volatile("s_waitcnt vmcnt(0)" ::: "memory"); __syncthreads();
                  if (tid == 0) { __builtin_amdgcn_fence(__ATOMIC_RELEASE, "agent"); asm volatile("s_waitcnt vmcnt(0)" ::: "memory");
                                  __hip_atomic_fetch_add(scnt, 1u, __ATOMIC_RELAXED, __HIP_MEMORY_SCOPE_AGENT); } }
              else if (it < Q1) { asm volatile("; MARK_ITEM_ATT" ::: "memory"); const int i2 = it - QS; att::attn_item((char*)lds_raw, PROJ, MIX, (i2 & 15) >> 3, i2 & 7, 31 - (i2 >> 4), fresh_tid(), a->in[13] + (size_t)l * 128, a->in[14] + (size_t)l * 128, a->out + O_KP + (size_t)l * MP * 1024); }
              else if (it < Q2) { asm volatile("; MARK_ITEM_SATT" ::: "memory"); sattn_item((LAS float*)lds, PROJ, MIX, it - Q1, l, a, fresh_tid()); }
              else if (it < Q2b) { asm volatile("; MARK_ITEM_CM" ::: "memory"); cm_item(lds, PROJ, MIX, it - Q2, l, a, fresh_tid()); }
              else { asm volatile("; MARK_ITEM_GLA" ::: "memory");
                  if (LC[3] == 0u) {
                      if (tid == 0) { unsigned sp = 0u; while (__hip_atomic_load(scnt, __ATOMIC_RELAXED, __HIP_MEMORY_SCOPE_AGENT) < (unsigned)QS) { __builtin_amdgcn_s_sleep(2); if (++sp > (1u << 22)) break; }
                                      __builtin_amdgcn_fence(__ATOMIC_ACQUIRE, "agent"); asm volatile("s_waitcnt vmcnt(0)" ::: "memory"); }
                      __syncthreads();
                      if (tid == 0) LC[3] = 1u; }
                  const int gi = it - Q2b;
                  if (gi < 32) gla_mix_item(lds, PROJ, MIX, NGLA_P + gi, l, a, (const float*)(ws + WS_GLAU), (const float*)(ws + WS_GLAD), fresh_tid());
                  else gla_chunk_item(lds, PROJ, MIX, gi - 32, l, a, (const float*)(ws + WS_GLAU), ws + WS_GLAF, fresh_tid()); }
              PROBE_IT1(it < QS ? 4 : it < Q1 ? 1 : it < Q2 ? 2 : it < Q2b ? 3 : 0);
          } }
        GRID_BAR(); PROBE_ACC(4);
        { PH_IDS(); asm volatile("; MARK_PHASE_6" ::: "memory"); pg8::Gemm g{(const bf16*)(ws + WS_MIX), (const bf16*)(ws + WS_W + (size_t)l * SZ_WL + SZ_WIN), MT, DM, DM}; pg8::SplitOrder S; S.init(MP, DM, DM, G, bx, 4, WGM_OUT);
          pg8::EpiResF32 E{nullptr, DM, MR, (float*)(ws + WS_PART), (bf16*)(ws + WS_H), (float*)(ws + WS_SSP)};
          PROBE_KIND(1); pg8::gemm_phase<pg8::EpiResF32, pg8::SplitOrder, true, true>(lds, g, S, E); }
        GRID_BAR(); PROBE_ACC(5);
        { PH_IDS(); asm volatile("; MARK_PHASE_7" ::: "memory"); sample_rows_phase(a->out, (bf16*)(ws + WS_H), (float*)(ws + WS_SS2), (const float*)(ws + WS_SSP), (const float*)(ws + WS_PART), NP_OUT, lds, bx, G, tid); }
        GRID_BAR(); PROBE_ACC(6);
        { PH_IDS(); asm volatile("; MARK_PHASE_8" ::: "memory"); pg8::Gemm g{(const bf16*)(ws + WS_H), (const bf16*)(ws + WS_W + (size_t)l * SZ_WL + SZ_WIN + SZ_WOUT), MT, NGU, DM}; pg8::SplitOrder S; S.init(MP, NGU, DM, G, bx, GU_PNT, WGM_GU);
          pg8::EpiConv E{(bf16*)(ws + WS_HID), a->in[19] + (size_t)l * 3 * FF, a->in[20] + (size_t)l * FF, (float*)(ws + WS_GH), (float*)(ws + WS_SBR),
                         a->out + O_CP + (size_t)l * NBATCH * 2 * FF, a->out + O_CS + (size_t)l * DECB * 2 * FF, a->in[5] + (size_t)l * DECB * 2 * FF, FF, MP, MR, SEQ, (const float*)(ws + WS_SS2), 1.f / DM, EPS, (float*)(ws + WS_PGU), GU_PNT};
          PROBE_KIND(2); pg8::gemm_phase<pg8::EpiConv, pg8::SplitOrder, true, true>(lds, g, S, E); }
        GRID_BAR(); PROBE_ACC(7);
        { PH_IDS(); asm volatile("; MARK_PHASE_9" ::: "memory"); conv_fix_phase((const float*)(ws + WS_GH), (const float*)(ws + WS_SBR), (bf16*)(ws + WS_HID), (const float*)(ws + WS_PGU), (const float*)(ws + WS_SS2), l, a, gtid, GT); }
        GRID_BAR(); PROBE_ACC(8);
        { PH_IDS(); asm volatile("; MARK_PHASE_10" ::: "memory"); pg8::Gemm g{(const bf16*)(ws + WS_HID), (const bf16*)(ws + WS_W + (size_t)l * SZ_WL + SZ_WIN + SZ_WOUT + SZ_WGU), MT, DM, FF}; pg8::SplitOrder S; S.init(MP, DM, FF, G, bx, 4, WGM_DN);
          pg8::EpiResF32 E{l == NL - 1 ? a->out : nullptr, DM, MR, (float*)(ws + WS_PART), (bf16*)(ws + WS_H), (float*)(ws + WS_SSP)};
          PROBE_KIND(3); pg8::gemm_phase<pg8::EpiResF32, pg8::SplitOrder, true, true>(lds, g, S, E); }
        GRID_BAR(); PROBE_ACC(9);
    }
    { PH_IDS(); sample_rows_phase(a->out, nullptr, nullptr, nullptr, (const float*)(ws + WS_PART), NP_DN, lds, bx, G, tid); }
#ifdef PROBE_SEL
    if (blockIdx.x == 0 && threadIdx.x == 0) { volatile LAS unsigned* LC_ = (volatile LAS unsigned*)(lds + LCTL_OFF); unsigned tot = 0;
        for (int k = 0; k < 10; ++k) if ((PROBE_SEL >> k) & 1) tot += LC_[16 + k];
        for (int k = 0; k < 12; ++k) if ((PROBE_SEL >> (16 + k)) & 1) tot += LC_[32 + k];
        const unsigned t0 = (unsigned)__builtin_amdgcn_s_memrealtime(); while ((unsigned)__builtin_amdgcn_s_memrealtime() - t0 < tot) __builtin_amdgcn_s_sleep(8); }
#endif
}

extern "C" void kernel_launch(void* const* d_in, const int* in_sizes, int n_in, void* d_out, int out_size, void* d_ws, size_t ws_size, hipStream_t stream) {
    static int grid = 0;
    if (grid == 0) {
        if (n_in != 22 || (size_t)out_size != O_END || ws_size < WS_END) { fprintf(stderr, "kernel_launch: unexpected shapes (n_in %d, out %d want %zu, ws %zu want >= %zu); nothing launched\n", n_in, out_size, (size_t)O_END, ws_size, (size_t)WS_END); grid = -1; return; }
        int dev = 0, cus = 0, per_cu = 0;
        if (hipGetDevice(&dev) != hipSuccess || hipDeviceGetAttribute(&cus, hipDeviceAttributeMultiprocessorCount, dev) != hipSuccess) { grid = -1; return; }
        if (hipFuncSetAttribute((const void*)fwd, hipFuncAttributeMaxDynamicSharedMemorySize, LDS_BYTES) != hipSuccess) { fprintf(stderr, "kernel_launch: hipFuncSetAttribute failed\n"); grid = -1; return; }
        if (hipOccupancyMaxActiveBlocksPerMultiprocessor(&per_cu, (const void*)fwd, NTHR, LDS_BYTES) != hipSuccess || per_cu < 1) { fprintf(stderr, "kernel_launch: occupancy query reports %d blocks per CU\n", per_cu); }
        (void)hipGetLastError();
        grid = cus;
    }
    if (grid < 0) return;
    (void)hipMemsetAsync((char*)d_ws + WS_CTL, 0, CTL_ZERO_BYTES, stream);
    Args a{};
    for (int i = 0; i < 22; ++i) a.in[i] = (const float*)d_in[i];
    a.out = (float*)d_out; a.ws = (unsigned char*)d_ws;
    hipLaunchKernelGGL(fwd, dim3(grid), dim3(NTHR), LDS_BYTES, stream, a);
}
```
